# Optimizing an MI355X kernel written in HIP

```python
import math
import jax, jax.numpy as jnp
from jax import lax
import numpy as np


D_MODEL = 1024
BATCH = 16
SEQ = 256
DEPTH = 2
DEC_BATCH = 2
DEC_SEQ = 2048
PAST_LEN = 256

GRID_W = 64
ROPE_THETA = 10000.0
Q_BLOCK = 128
EPS = 1e-6
N_MOD = 9
D_FF = ((8 * D_MODEL // 3 + 127) // 128) * 128

W_SCONV = D_MODEL // 4
SCONV_K = 3
N_HEADS_DIFF = 4
DV_DIFF = D_MODEL // 4 // N_HEADS_DIFF
DK_DIFF = DV_DIFF // 2
W_CCM = D_MODEL // 4
CCM_K = 31
N_HEADS_GQA = 4
N_KV_GQA = 2
HD_GQA = D_MODEL // 4 // N_HEADS_GQA
G_GQA = N_HEADS_GQA // N_KV_GQA

SPLIT_SIZES = (W_SCONV, W_SCONV, W_SCONV,
               N_HEADS_DIFF * 2 * DK_DIFF, N_HEADS_DIFF * 2 * DK_DIFF, N_HEADS_DIFF * DV_DIFF,
               W_CCM, W_CCM,
               N_HEADS_GQA * HD_GQA, N_KV_GQA * HD_GQA, N_KV_GQA * HD_GQA)
MIX_IN = 3 * W_SCONV + 2 * N_HEADS_DIFF * 2 * DK_DIFF + N_HEADS_DIFF * DV_DIFF + 2 * W_CCM + N_HEADS_GQA * HD_GQA + 2 * N_KV_GQA * HD_GQA
MIX_WIDTH = W_SCONV + N_HEADS_DIFF * DV_DIFF + W_CCM + N_HEADS_GQA * HD_GQA

kernel_name = "hybrid_diffusion_parallel_groups_step"


def rms_norm(x, g):
    xf = x.astype(jnp.float32)
    y = xf * lax.rsqrt(jnp.mean(xf * xf, axis=-1, keepdims=True) + EPS)
    return (y * g.astype(jnp.float32)).astype(x.dtype)


def layer_norm(x, g, b):
    xf = x.astype(jnp.float32)
    mu = jnp.mean(xf, axis=-1, keepdims=True)
    var = jnp.mean(jnp.square(xf - mu), axis=-1, keepdims=True)
    y = (xf - mu) * lax.rsqrt(var + EPS)
    return (y * g.astype(jnp.float32) + b.astype(jnp.float32)).astype(x.dtype)


def depthwise_conv(x, w):
    k = w.shape[0]
    return lax.conv_general_dilated(
        x, w[:, None, :].astype(x.dtype), window_strides=(1,), padding=[(k // 2, k // 2)],
        dimension_numbers=("NWC", "WIO", "NWC"), feature_group_count=x.shape[-1])


def swiglu(h, wg, wu, wd):
    return (jax.nn.silu(h @ wg) * (h @ wu)) @ wd


def axial_angles(n_tokens, rot_dim):
    n_rows = n_tokens // GRID_W
    row = jnp.repeat(jnp.arange(n_rows, dtype=jnp.float32), GRID_W)
    col = jnp.tile(jnp.arange(GRID_W, dtype=jnp.float32), n_rows)
    n_freq = rot_dim // 4
    inv = ROPE_THETA ** (-jnp.arange(n_freq, dtype=jnp.float32) / n_freq)
    return row[:, None] * inv, col[:, None] * inv


def _rotate(x, ang):
    m = x.shape[-1] // 2
    shape = (ang.shape[0],) + (1,) * (x.ndim - 3) + (m,)
    cos = jnp.cos(ang).reshape(shape).astype(x.dtype)
    sin = jnp.sin(ang).reshape(shape).astype(x.dtype)
    x1, x2 = x[..., :m], x[..., m:]
    return jnp.concatenate([x1 * cos - x2 * sin, x1 * sin + x2 * cos], axis=-1)


def axial_rope(x, angles):
    ang_row, ang_col = angles
    half = x.shape[-1] // 2
    return jnp.concatenate([_rotate(x[..., :half], ang_row), _rotate(x[..., half:], ang_col)], axis=-1)


def _to_blocks(q):
    b, t = q.shape[:2]
    return q.reshape((b, t // Q_BLOCK, Q_BLOCK) + q.shape[2:]).swapaxes(0, 1)


def _from_blocks(o):
    nb, b = o.shape[:2]
    return o.swapaxes(0, 1).reshape((b, nb * Q_BLOCK) + o.shape[3:])


def diff_attention(q, k, v, lam):
    scale = q.shape[-1] ** -0.5

    def block(qb):
        s = jnp.einsum("bqhmd,bshmd->bhmqs", qb, k).astype(jnp.float32) * scale
        p = jax.nn.softmax(s, axis=-1)
        w = p[:, :, 0] - lam * p[:, :, 1]
        return jnp.einsum("bhqs,bshd->bqhd", w.astype(v.dtype), v)

    return _from_blocks(lax.map(block, _to_blocks(q)))


def gqa_attention(q, k, v):
    scale = q.shape[-1] ** -0.5

    def block(qb):
        s = jnp.einsum("bqkgd,bskd->bkgqs", qb, k).astype(jnp.float32) * scale
        p = jax.nn.softmax(s, axis=-1)
        return jnp.einsum("bkgqs,bskd->bqkgd", p.astype(v.dtype), v)

    return _from_blocks(lax.map(block, _to_blocks(q)))


def token_mix(h, l, p, angles, ctx_kv):
    bsz, t, _ = h.shape
    points = []
    acc = 0
    for s in SPLIT_SIZES[:-1]:
        acc += s
        points.append(acc)
    proj = h @ p["w_mix_in"][l]
    a_b, a_c, a_h, b_q, b_k, b_v, c_a, c_g, d_q, d_k, d_v = jnp.split(proj, points, axis=-1)

    a_out = a_b * depthwise_conv(a_c * a_h, p["sconv_w"][l])

    bq = b_q.reshape(bsz, t, N_HEADS_DIFF, 2, DK_DIFF)
    bk = b_k.reshape(bsz, t, N_HEADS_DIFF, 2, DK_DIFF)
    bv = b_v.reshape(bsz, t, N_HEADS_DIFF, DV_DIFF)
    dq = rms_norm(d_q.reshape(bsz, t, N_HEADS_GQA, HD_GQA), p["gqa_qnorm"][l])
    dk = rms_norm(d_k.reshape(bsz, t, N_KV_GQA, HD_GQA), p["gqa_knorm"][l])
    dv = d_v.reshape(bsz, t, N_KV_GQA, HD_GQA)
    own = (bk, bv, dk, dv)

    if angles is not None:
        ang_diff, ang_gqa = angles
        bq = axial_rope(bq, ang_diff)
        bk = axial_rope(bk, ang_diff)
        dq = axial_rope(dq, ang_gqa)
        dk = axial_rope(dk, ang_gqa)
    if ctx_kv is not None:
        cbk, cbv, cdk, cdv = ctx_kv
        bk = jnp.concatenate([cbk, bk], axis=1)
        bv = jnp.concatenate([cbv, bv], axis=1)
        dk = jnp.concatenate([cdk, dk], axis=1)
        dv = jnp.concatenate([cdv, dv], axis=1)

    lam_init = 0.8 - 0.6 * math.exp(-0.3 * l)
    f32 = jnp.float32
    lam = (jnp.exp(jnp.sum(p["diff_lq1"][l].astype(f32) * p["diff_lk1"][l].astype(f32)))
           - jnp.exp(jnp.sum(p["diff_lq2"][l].astype(f32) * p["diff_lk2"][l].astype(f32)))
           + lam_init)
    b_out = diff_attention(bq, bk, bv, lam)
    b_out = (rms_norm(b_out, p["diff_subln"][l]) * (1.0 - lam_init)).reshape(bsz, t, -1)

    u = c_a * jax.nn.sigmoid(c_g)
    u = depthwise_conv(u, p["ccm_dw_w"][l]) + p["ccm_dw_b"][l]
    u = jax.nn.silu(layer_norm(u, p["ccm_ln_g"][l], p["ccm_ln_b"][l]))
    c_out = u @ p["ccm_pw"][l]

    d_out = gqa_attention(dq.reshape(bsz, t, N_KV_GQA, G_GQA, HD_GQA), dk, dv).reshape(bsz, t, -1)

    out = jnp.concatenate([a_out, b_out, c_out, d_out], axis=-1) @ p["w_mix_out"][l]
    return out, own


def trunk_layer(x, cond, l, p, angles, ctx_kv):
    m = jax.nn.silu(cond) @ p["w_ada"][l] + p["b_ada"][l]
    m = m.reshape(m.shape[0], 1, N_MOD, D_MODEL)
    shift, scale, gate = m[:, :, 0::3], m[:, :, 1::3], m[:, :, 2::3]

    def pre(y, i):
        return rms_norm(y, p["norm_pre"][l, i]) * (1.0 + scale[:, :, i]) + shift[:, :, i]

    def post(y, i):
        return gate[:, :, i] * rms_norm(y, p["norm_post"][l, i])

    x = x + 0.5 * post(swiglu(pre(x, 0), p["ffn1_gate"][l], p["ffn1_up"][l], p["ffn1_down"][l]), 0)
    y, own = token_mix(pre(x, 1), l, p, angles, ctx_kv)
    x = x + post(y, 1)
    x = x + 0.5 * post(swiglu(pre(x, 2), p["ffn2_gate"][l], p["ffn2_up"][l], p["ffn2_down"][l]), 2)
    return x, own


def setup_inputs(seed: int = 0) -> dict:
    key = jax.random.key(seed)
    ks = iter(jax.random.split(key, 48))
    D = D_MODEL

    def nrm(shape, s):
        return jax.random.normal(next(ks), shape, jnp.float32) * s

    def gain(shape):
        return 1.0 + nrm(shape, 0.02)

    return {
        "x_prompt": nrm((BATCH, SEQ, D), 1.0),
        "x_sample": nrm((DEC_BATCH, DEC_SEQ, D), 1.0),
        "cache_diff_k": nrm((DEC_BATCH, DEPTH, PAST_LEN, N_HEADS_DIFF, 2, DK_DIFF), 1.0),
        "cache_diff_v": nrm((DEC_BATCH, DEPTH, PAST_LEN, N_HEADS_DIFF, DV_DIFF), 1.0),
        "cache_gqa_k": nrm((DEC_BATCH, DEPTH, PAST_LEN, N_KV_GQA, HD_GQA), 1.0),
        "cache_gqa_v": nrm((DEC_BATCH, DEPTH, PAST_LEN, N_KV_GQA, HD_GQA), 1.0),
        "c": nrm((DEC_BATCH, D), 1.0),
        "c_ctx": nrm((D,), 1.0),
        "w_ada": nrm((DEPTH, D, N_MOD * D), 0.5 * D ** -0.5),
        "b_ada": nrm((DEPTH, N_MOD * D), 0.02),
        "norm_pre": gain((DEPTH, 3, D)),
        "norm_post": gain((DEPTH, 3, D)),
        "ffn1_gate": nrm((DEPTH, D, D_FF), D ** -0.5),
        "ffn1_up": nrm((DEPTH, D, D_FF), D ** -0.5),
        "ffn1_down": nrm((DEPTH, D_FF, D), D_FF ** -0.5),
        "ffn2_gate": nrm((DEPTH, D, D_FF), D ** -0.5),
        "ffn2_up": nrm((DEPTH, D, D_FF), D ** -0.5),
        "ffn2_down": nrm((DEPTH, D_FF, D), D_FF ** -0.5),
        "w_mix_in": nrm((DEPTH, D, MIX_IN), D ** -0.5),
        "w_mix_out": nrm((DEPTH, MIX_WIDTH, D), MIX_WIDTH ** -0.5),
        "sconv_w": nrm((DEPTH, SCONV_K, W_SCONV), SCONV_K ** -0.5),
        "diff_lq1": nrm((DEPTH, DK_DIFF), 0.1),
        "diff_lk1": nrm((DEPTH, DK_DIFF), 0.1),
        "diff_lq2": nrm((DEPTH, DK_DIFF), 0.1),
        "diff_lk2": nrm((DEPTH, DK_DIFF), 0.1),
        "diff_subln": gain((DEPTH, DV_DIFF)),
        "ccm_dw_w": nrm((DEPTH, CCM_K, W_CCM), CCM_K ** -0.5),
        "ccm_dw_b": nrm((DEPTH, W_CCM), 0.02),
        "ccm_ln_g": gain((DEPTH, W_CCM)),
        "ccm_ln_b": nrm((DEPTH, W_CCM), 0.02),
        "ccm_pw": nrm((DEPTH, W_CCM, W_CCM), W_CCM ** -0.5),
        "gqa_qnorm": gain((DEPTH, HD_GQA)),
        "gqa_knorm": gain((DEPTH, HD_GQA)),
    }


def reference(x_prompt, x_sample, cache_diff_k, cache_diff_v, cache_gqa_k, cache_gqa_v, c, c_ctx,
              w_ada, b_ada, norm_pre, norm_post,
              ffn1_gate, ffn1_up, ffn1_down, ffn2_gate, ffn2_up, ffn2_down,
              w_mix_in, w_mix_out, sconv_w,
              diff_lq1, diff_lk1, diff_lq2, diff_lk2, diff_subln,
              ccm_dw_w, ccm_dw_b, ccm_ln_g, ccm_ln_b, ccm_pw,
              gqa_qnorm, gqa_knorm):
    p = dict(w_ada=w_ada, b_ada=b_ada, norm_pre=norm_pre, norm_post=norm_post,
             ffn1_gate=ffn1_gate, ffn1_up=ffn1_up, ffn1_down=ffn1_down,
             ffn2_gate=ffn2_gate, ffn2_up=ffn2_up, ffn2_down=ffn2_down,
             w_mix_in=w_mix_in, w_mix_out=w_mix_out, sconv_w=sconv_w,
             diff_lq1=diff_lq1, diff_lk1=diff_lk1, diff_lq2=diff_lq2, diff_lk2=diff_lk2,
             diff_subln=diff_subln, ccm_dw_w=ccm_dw_w, ccm_dw_b=ccm_dw_b,
             ccm_ln_g=ccm_ln_g, ccm_ln_b=ccm_ln_b, ccm_pw=ccm_pw,
             gqa_qnorm=gqa_qnorm, gqa_knorm=gqa_knorm)

    x = x_prompt
    dks, dvs, gks, gvs = [], [], [], []
    for l in range(DEPTH):
        x, own = trunk_layer(x, c_ctx[None, :], l, p, None, None)
        dks.append(own[0])
        dvs.append(own[1])
        gks.append(own[2])
        gvs.append(own[3])
    y_prompt = x
    new_diff_k = jnp.stack(dks, axis=1)
    new_diff_v = jnp.stack(dvs, axis=1)
    new_gqa_k = jnp.stack(gks, axis=1)
    new_gqa_v = jnp.stack(gvs, axis=1)

    t_lat = x_sample.shape[1]
    angles = (axial_angles(t_lat, DK_DIFF), axial_angles(t_lat, HD_GQA))
    x = x_sample
    for l in range(DEPTH):
        ctx_kv = (cache_diff_k[:, l], cache_diff_v[:, l], cache_gqa_k[:, l], cache_gqa_v[:, l])
        x, _ = trunk_layer(x, c, l, p, angles, ctx_kv)
    y_sample = x

    return (y_prompt, y_sample, new_diff_k, new_diff_v, new_gqa_k, new_gqa_v)
```

```cpp
#include <hip/hip_runtime.h>
#include <hip/hip_cooperative_groups.h>
#include <cstdio>
#include <cstdint>
namespace cg = cooperative_groups;
#ifndef PROBE
#define PROBE 0
#endif
#define NREP(k) ((PROBE == (k)) ? 3 : 1)

typedef unsigned short bf16_t;
typedef short bf16x8 __attribute__((ext_vector_type(8)));
typedef float f32x4 __attribute__((ext_vector_type(4)));
typedef float f32x16 __attribute__((ext_vector_type(16)));
typedef unsigned u32x4 __attribute__((ext_vector_type(4)));
typedef unsigned u32x2 __attribute__((ext_vector_type(2)));
#define LAS __attribute__((address_space(3)))

constexpr int D = 1024, TOK = 8192, CTX_TOK = 4096, DFF = 2816, NGU = 5632, MIXIN = 2560;
constexpr int SEQ_C = 256, SEQ_L = 2048, S_LAT = 2304, NMOD = 9216;
constexpr float EPS = 1e-6f;
constexpr float LOG2E = 1.4426950408889634f;

constexpr size_t MiB = 1u << 20;
constexpr size_t WS_CTL = 0;
constexpr size_t WS_MODP = 64 * 1024;
constexpr size_t WS_W = 2 * MiB, WL = 40 * MiB;
constexpr size_t WO_GU1 = 0, WO_D1 = 11 * MiB, WO_GU2 = 16 * MiB + 512 * 1024, WO_D2 = 27 * MiB + 512 * 1024, WO_MI = 33 * MiB, WO_MO = 38 * MiB;
constexpr size_t WS_H = 82 * MiB, WS_CAT = 98 * MiB, WS_ACT = 114 * MiB, WS_Y = 158 * MiB;
constexpr size_t WS_QD = 222 * MiB, WS_QG = 226 * MiB;
constexpr size_t WS_KDC = 230 * MiB, WS_VDC = 232 * MiB, WS_KGC = 234 * MiB, WS_VGC = 235 * MiB;
constexpr size_t WS_KDL = 236 * MiB, WS_VDL = 239 * MiB, WS_KGL = 242 * MiB, WS_VGL = 244 * MiB, WS_TAB = 246 * MiB, WS_END = 247 * MiB;

constexpr int LDS_BYTES = 131072 + 12288 + 64;

__device__ __forceinline__ float wave_sum(float v) {
#pragma unroll
    for (int o = 1; o < 64; o <<= 1) v += __shfl_xor(v, o);
    return v;
}
__device__ __forceinline__ unsigned f2bf(float f) { unsigned u = __builtin_bit_cast(unsigned, f); return (u + 0x7fffu + ((u >> 16) & 1u)) >> 16; }
typedef float f32x2_cv __attribute__((ext_vector_type(2))); typedef __bf16 bf16x2_cv __attribute__((ext_vector_type(2)));
__device__ __forceinline__ unsigned pk2(float lo, float hi) { f32x2_cv v = {lo, hi}; bf16x2_cv b = __builtin_convertvector(v, bf16x2_cv); return __builtin_bit_cast(unsigned, b); }
__device__ __forceinline__ float bf2f(bf16_t h) { return __builtin_bit_cast(float, (unsigned)h << 16); }
__device__ __forceinline__ float silu_f(float v) { return v * __builtin_amdgcn_rcpf(1.0f + __builtin_amdgcn_exp2f(-1.4426950408889634f * v)); }
__device__ __forceinline__ int tid_now() { int t = threadIdx.x; asm volatile("" : "+v"(t)); return t; }

namespace pg8 {
constexpr int BM = 256, BK = 64, HALF = 128, HTB = HALF * BK * 2, NXCD = 8, WGM = 8;
__host__ __device__ __forceinline__ int lds_byte(int r, int c) { const int st = (r >> 4) * 2 + (c >> 5), rr = r & 15, cc = c & 31, ob = rr * 64 + cc * 2; return st * 1024 + (ob ^ (((ob >> 9) & 1) << 5)); }
__host__ __device__ __forceinline__ void stage_rc(int b, int& R, int& C) { const int st = b / 1024, sb = b % 1024, swz = sb ^ (((sb >> 9) & 1) << 5); R = (st >> 1) * 16 + swz / 64; C = (st & 1) * 32 + (swz % 64) / 2; }
__host__ __device__ __forceinline__ int perm32(int rho) { const int n = rho >> 4, i = rho & 15; return 8 * (i >> 2) + 4 * n + (i & 3); }

struct Unit { int pm, pn, ks, nt, koff; };
struct Gemm { const bf16_t* A; const bf16_t* Bt; int ld; };

struct StaticOrder {
    int nM, nN, nNr, nwg, G, c, Kloop;
    __device__ void init(int M, int N, int KS, int G_, int c_, int Kloop_) { nM = M / BM; nNr = N / BM; nN = nNr * KS; nwg = nM * nN; G = G_; c = c_; Kloop = Kloop_; }
    __device__ bool next(int i, Unit& u) const {
        const long L = (long)i * G + c; if (L >= nwg) return false;
        int wgid = (int)L; { const int q = nwg / NXCD, r = nwg % NXCD, xcd = wgid % NXCD, off = wgid / NXCD; wgid = (xcd < r ? xcd * (q + 1) : r * (q + 1) + (xcd - r) * q) + off; }
        const int nig = WGM * nN, gid = wgid / nig, fm = gid * WGM, gsz = (nM - fm) < WGM ? (nM - fm) : WGM;
        u.pm = fm + ((wgid % nig) % gsz); const int pv = (wgid % nig) / gsz; u.pn = pv % nNr; u.ks = pv / nNr; u.nt = Kloop / BK; u.koff = u.ks * Kloop * 2; return true;
    }
};

struct MixInOrder {
    StaticOrder S8; int G, c;
    __device__ void init(int G_, int c_) { S8.init(TOK, 2048, 1, G_, c_, D); G = G_; c = c_; }
    __device__ bool next(int i, Unit& u) const {
        const long L = (long)i * G + c;
        if (L < 256) return S8.next(i, u);
        if (L >= 512) return false;
        const int idx = (int)L - 256, r = idx & 7; u.pm = idx >> 3; u.pn = 8 + (r & 1); u.ks = r >> 1; u.nt = 4; u.koff = u.ks * 512; return true;
    }
};

__device__ __forceinline__ unsigned cvt_pk_bf16(float lo, float hi) { f32x2_cv v = {lo, hi}; bf16x2_cv b = __builtin_convertvector(v, bf16x2_cv); return __builtin_bit_cast(unsigned, b); }

struct EpiBf16 {
    static constexpr bool PERM = true;
    bf16_t* O; int ldc; size_t ks_stride;
    __device__ __forceinline__ void operator()(const f32x4 (&acc)[2][2][4][2], const Unit& u, int wr, int wc, int fr, int fq) const {
        bf16_t* Ob = O + (size_t)u.ks * ks_stride;
        const int row0 = u.pm * BM + wr * 64 + fr; const int col0 = u.pn * BM + wc * 32 + 8 * fq;
#pragma unroll
        for (int ai = 0; ai < 2; ++ai)
#pragma unroll
            for (int m = 0; m < 4; ++m) { bf16_t* rowp = Ob + (size_t)(row0 + ai * HALF + m * 16) * ldc + col0;
#pragma unroll
                for (int bj = 0; bj < 2; ++bj) { const f32x4 v0 = acc[ai][bj][m][0], v1 = acc[ai][bj][m][1];
                    u32x4 w; w.x = cvt_pk_bf16(v0[0], v0[1]); w.y = cvt_pk_bf16(v0[2], v0[3]); w.z = cvt_pk_bf16(v1[0], v1[1]); w.w = cvt_pk_bf16(v1[2], v1[3]);
                    *(u32x4*)(rowp + bj * HALF) = w; } }
    }
};
struct EpiMixIn {
    static constexpr bool PERM = true;
    bf16_t* PROJ; bf16_t* PART;
    __device__ __forceinline__ void operator()(const f32x4 (&acc)[2][2][4][2], const Unit& u, int wr, int wc, int fr, int fq) const {
        const bool part = u.pn >= 8;
        bf16_t* Ob = part ? PART + (size_t)u.ks * TOK * 512 : PROJ; const int ldc = part ? 512 : MIXIN;
        const int row0 = u.pm * BM + wr * 64 + fr; const int col0 = (part ? u.pn - 8 : u.pn) * BM + wc * 32 + 8 * fq;
#pragma unroll
        for (int ai = 0; ai < 2; ++ai)
#pragma unroll
            for (int m = 0; m < 4; ++m) { bf16_t* rowp = Ob + (size_t)(row0 + ai * HALF + m * 16) * ldc + col0;
#pragma unroll
                for (int bj = 0; bj < 2; ++bj) { const f32x4 v0 = acc[ai][bj][m][0], v1 = acc[ai][bj][m][1];
                    u32x4 w; w.x = cvt_pk_bf16(v0[0], v0[1]); w.y = cvt_pk_bf16(v0[2], v0[3]); w.z = cvt_pk_bf16(v1[0], v1[1]); w.w = cvt_pk_bf16(v1[2], v1[3]);
                    *(u32x4*)(rowp + bj * HALF) = w; } }
    }
};
struct EpiSwiGLU {
    static constexpr bool PERM = true;
    bf16_t* O;
    __device__ __forceinline__ void operator()(const f32x4 (&acc)[2][2][4][2], const Unit& u, int wr, int wc, int fr, int fq) const {
        const int row0 = u.pm * BM + wr * 64 + fr; const int col0 = u.pn * HALF + wc * 32 + 8 * fq;
#pragma unroll
        for (int ai = 0; ai < 2; ++ai)
#pragma unroll
            for (int m = 0; m < 4; ++m) { bf16_t* rowp = O + (size_t)(row0 + ai * HALF + m * 16) * DFF + col0;
                const f32x4 g0 = acc[ai][0][m][0], g1 = acc[ai][0][m][1], u0 = acc[ai][1][m][0], u1 = acc[ai][1][m][1];
                float r[8];
#pragma unroll
                for (int i = 0; i < 4; ++i) { r[i] = silu_f(g0[i]) * u0[i]; r[4 + i] = silu_f(g1[i]) * u1[i]; }
                u32x4 w; w.x = cvt_pk_bf16(r[0], r[1]); w.y = cvt_pk_bf16(r[2], r[3]); w.z = cvt_pk_bf16(r[4], r[5]); w.w = cvt_pk_bf16(r[6], r[7]);
                *(u32x4*)rowp = w; }
    }
};
struct EpiF32 {
    static constexpr bool PERM = false;
    float* O; int ldc; size_t ks_stride;
    __device__ __forceinline__ void operator()(const f32x4 (&acc)[2][2][4][2], const Unit& u, int wr, int wc, int fr, int fq) const {
        float* base = O + (size_t)u.ks * ks_stride;
        const int row0 = u.pm * BM + wr * 64 + fr; const int col0 = u.pn * BM + wc * 32 + 4 * fq;
#pragma unroll
        for (int ai = 0; ai < 2; ++ai)
#pragma unroll
            for (int m = 0; m < 4; ++m) { float* rowp = base + (size_t)(row0 + ai * HALF + m * 16) * ldc + col0;
#pragma unroll
                for (int bj = 0; bj < 2; ++bj)
#pragma unroll
                    for (int n = 0; n < 2; ++n) *(f32x4*)(rowp + bj * HALF + n * 16) = acc[ai][bj][m][n]; }
    }
};

template <class Epi, class Sched>
__device__ __forceinline__ void gemm_phase(LAS unsigned char* lds, const Gemm g, const Sched& S, const Epi& E) {
    const int tid = tid_now(), wid = __builtin_amdgcn_readfirstlane(tid >> 6), lane = tid & 63, wr = wid >> 2, wc = wid & 3, fr = lane & 15, fq = lane >> 4;
    const int K = g.ld;
    unsigned voffA[2], voffB[2];
#pragma unroll
    for (int i = 0; i < 2; ++i) { int R, C; stage_rc(tid * 16 + i * 8192, R, C); const int Rb = Epi::PERM ? ((R & ~31) + perm32(R & 31)) : R;
        voffA[i] = (unsigned)(R * K + C) * 2u; voffB[i] = (unsigned)(Rb * K + C) * 2u; }
    const size_t kstep = (size_t)(BK * 2);
    const size_t hstep = (size_t)HALF * K * 2;
    const size_t tstep = 2 * hstep;
    const unsigned ldsw = (unsigned)wid * 1024u;
    const int aoff = lds_byte(wr * 64 + fr, fq * 8), boff = lds_byte(wc * 32 + fr, fq * 8);
#define PG8_SA(b, h) (((b) * 2 + (h)) * HTB)
#define PG8_SB(b, h) ((4 + (b) * 2 + (h)) * HTB)
#define PG8_STAGE(bufoff, gbase, voff) do { _Pragma("unroll") for (int _i = 0; _i < 2; ++_i) \
        __builtin_amdgcn_global_load_lds((const unsigned*)((const char*)(gbase) + (voff)[_i]), (LAS unsigned*)(lds + (bufoff) + ldsw + _i * 8192), 16, 0, 0); } while (0)
#define PG8_LDA(dst, b, h) do { _Pragma("unroll") for (int m = 0; m < 4; ++m) _Pragma("unroll") for (int k = 0; k < 2; ++k) dst[m][k] = *(const LAS bf16x8*)(lds + PG8_SA(b, h) + aoff + m * 2048 + k * 1024); } while (0)
#define PG8_LDB(dst, b, h) do { _Pragma("unroll") for (int n = 0; n < 2; ++n) _Pragma("unroll") for (int k = 0; k < 2; ++k) dst[n][k] = *(const LAS bf16x8*)(lds + PG8_SB(b, h) + boff + n * 2048 + k * 1024); } while (0)
#define PG8_MMA(ai, bj, At, Bt) do { __builtin_amdgcn_s_setprio(1); _Pragma("unroll") for (int m = 0; m < 4; ++m) _Pragma("unroll") for (int n = 0; n < 2; ++n) _Pragma("unroll") for (int k = 0; k < 2; ++k) \
        acc[ai][bj][m][n] = __builtin_amdgcn_mfma_f32_16x16x32_bf16(Bt[n][k], At[m][k], acc[ai][bj][m][n], 0, 0, 0); __builtin_amdgcn_s_setprio(0); } while (0)
#define PG8_WAIT_V(n) asm volatile("s_waitcnt vmcnt(" #n ")" ::: "memory")
#define PG8_WAIT_L(n) asm volatile("s_waitcnt lgkmcnt(" #n ")" ::: "memory")
#define PG8_BAR __builtin_amdgcn_s_barrier()
#define PG8_SCHED __builtin_amdgcn_sched_barrier(0)
    Unit cur, nxt; int ui = 0;
    if (!S.next(0, cur)) return;
    f32x4 acc[2][2][4][2];
#pragma unroll
    for (int a = 0; a < 2; ++a)
#pragma unroll
        for (int b = 0; b < 2; ++b)
#pragma unroll
            for (int m = 0; m < 4; ++m)
#pragma unroll
                for (int n = 0; n < 2; ++n) acc[a][b][m][n] = (f32x4){0.f, 0.f, 0.f, 0.f};
    bf16x8 At[4][2], B0[2][2], B1[2][2];
    const char* cA = (const char*)g.A + (size_t)cur.pm * tstep + (size_t)cur.koff; const char* cB = (const char*)g.Bt + (size_t)cur.pn * tstep + (size_t)cur.koff;
    PG8_STAGE(PG8_SB(0, 0), cB, voffB); PG8_STAGE(PG8_SB(0, 1), cB + hstep, voffB); PG8_STAGE(PG8_SA(0, 0), cA, voffA); PG8_STAGE(PG8_SA(0, 1), cA + hstep, voffA);
    if (wr == 1) PG8_BAR;
    PG8_WAIT_V(2); PG8_BAR;
    PG8_STAGE(PG8_SB(1, 0), cB + kstep, voffB); PG8_STAGE(PG8_SA(1, 0), cA + kstep, voffA); PG8_STAGE(PG8_SB(1, 1), cB + hstep + kstep, voffB);
    PG8_WAIT_V(6); PG8_BAR;
    for (;;) {
        const bool has_next = S.next(ui + 1, nxt);
        const char* nA = has_next ? (const char*)g.A + (size_t)nxt.pm * tstep + (size_t)nxt.koff : cA; const char* nB = has_next ? (const char*)g.Bt + (size_t)nxt.pn * tstep + (size_t)nxt.koff : cB;
        const int nt = cur.nt;
        for (int t = 0; t < nt; t += 2) {
            const bool last = (t == nt - 2);
            const char* a1 = cA + (size_t)(t + 1) * kstep;
            const char* a2 = last ? nA : cA + (size_t)(t + 2) * kstep; const char* b2 = last ? nB : cB + (size_t)(t + 2) * kstep;
            const char* a3 = a2 + kstep; const char* b3 = b2 + kstep;
            PG8_LDB(B0, 0, 0); PG8_LDB(B1, 0, 1); PG8_SCHED; PG8_LDA(At, 0, 0); PG8_STAGE(PG8_SA(1, 1), a1 + hstep, voffA);
            PG8_WAIT_V(8); PG8_WAIT_L(0); PG8_BAR; PG8_MMA(0, 0, At, B0); PG8_MMA(0, 1, At, B1); PG8_BAR; PG8_SCHED;
            PG8_LDA(At, 0, 1); PG8_STAGE(PG8_SB(0, 0), b2, voffB); PG8_STAGE(PG8_SB(0, 1), b2 + hstep, voffB); PG8_STAGE(PG8_SA(0, 0), a2, voffA);
            PG8_WAIT_V(8); PG8_WAIT_L(0); PG8_BAR; PG8_MMA(1, 0, At, B0); PG8_MMA(1, 1, At, B1); PG8_BAR; PG8_SCHED;
            PG8_LDB(B0, 1, 0); PG8_LDB(B1, 1, 1); PG8_SCHED; PG8_LDA(At, 1, 0); PG8_STAGE(PG8_SA(0, 1), a2 + hstep, voffA);
            PG8_WAIT_V(8); PG8_WAIT_L(0); PG8_BAR; PG8_MMA(0, 0, At, B0); PG8_MMA(0, 1, At, B1); PG8_BAR; PG8_SCHED;
            PG8_LDA(At, 1, 1); PG8_STAGE(PG8_SB(1, 0), b3, voffB); PG8_STAGE(PG8_SB(1, 1), b3 + hstep, voffB); PG8_STAGE(PG8_SA(1, 0), a3, voffA);
            PG8_WAIT_V(8); PG8_WAIT_L(0); PG8_BAR; PG8_MMA(1, 0, At, B0); PG8_MMA(1, 1, At, B1); PG8_BAR; PG8_SCHED;
        }
        if (wr == 0) PG8_BAR;
        E(acc, cur, wr, wc, fr, fq);
        if (!has_next) break;
#pragma unroll
        for (int a = 0; a < 2; ++a)
#pragma unroll
            for (int b = 0; b < 2; ++b)
#pragma unroll
                for (int m = 0; m < 4; ++m)
#pragma unroll
                    for (int n = 0; n < 2; ++n) acc[a][b][m][n] = (f32x4){0.f, 0.f, 0.f, 0.f};
        cur = nxt; cA = nA; cB = nB; ++ui;
        if (wr == 1) PG8_BAR;
    }
    PG8_WAIT_V(0);
    PG8_BAR;
#undef PG8_SA
#undef PG8_SB
#undef PG8_STAGE
#undef PG8_LDA
#undef PG8_LDB
#undef PG8_MMA
#undef PG8_WAIT_V
#undef PG8_WAIT_L
#undef PG8_BAR
#undef PG8_SCHED
}
}

struct Args { const float* in[33]; float* out; unsigned char* ws; int ph_lo, ph_hi; };
enum { I_XP = 0, I_XS, I_CDK, I_CDV, I_CGK, I_CGV, I_C, I_CCTX, I_WADA, I_BADA, I_NPRE, I_NPOST, I_F1G, I_F1U, I_F1D, I_F2G, I_F2U, I_F2D,
       I_WMI, I_WMO, I_SCW, I_LQ1, I_LK1, I_LQ2, I_LK2, I_SUBLN, I_CDWW, I_CDWB, I_CLNG, I_CLNB, I_CPW, I_QNORM, I_KNORM };

__device__ __forceinline__ const float* inptr(int i) {
    typedef const char __attribute__((address_space(4)))* kptr_t;
    kptr_t kp = (kptr_t)__builtin_amdgcn_kernarg_segment_ptr();
    unsigned off = 8u * (unsigned)i; asm volatile("" : "+s"(off));
    return *(const float* const __attribute__((address_space(4)))*)(kp + off);
}
__device__ __forceinline__ void tr_item(const float* W, int ldw, bf16_t* WT, int ldt, int k0, int n0, int orow0, float* scr, int lane) {
    f32x4 v[8];
    const int lr = lane >> 3, lc = (lane & 7) * 4;
#pragma unroll
    for (int i = 0; i < 8; ++i) v[i] = *(const f32x4*)(W + (size_t)(k0 + 8 * i + lr) * ldw + n0 + lc);
#pragma unroll
    for (int i = 0; i < 8; ++i) { float* d = scr + (8 * i + lr) * 33 + lc; d[0] = v[i][0]; d[1] = v[i][1]; d[2] = v[i][2]; d[3] = v[i][3]; }
    asm volatile("s_waitcnt lgkmcnt(0)" ::: "memory");
    const int c = lane & 7;
#pragma unroll
    for (int j = 0; j < 4; ++j) { const int n = (lane >> 3) + 8 * j; const float* s = scr + (8 * c) * 33 + n;
        u32x4 o; o.x = pk2(s[0 * 33], s[1 * 33]); o.y = pk2(s[2 * 33], s[3 * 33]); o.z = pk2(s[4 * 33], s[5 * 33]); o.w = pk2(s[6 * 33], s[7 * 33]);
        *(u32x4*)(WT + (size_t)(orow0 + n) * ldt + k0 + 8 * c) = o; }
    asm volatile("s_waitcnt lgkmcnt(0)" ::: "memory");
}

__device__ __forceinline__ void p0_prologue(const Args& a, unsigned char* lds, int vcu, int NGW) {
    const int tid = tid_now(), lane = tid & 63, wave = __builtin_amdgcn_readfirstlane(tid >> 6), gw = vcu * 8 + wave;
    float* SC = (float*)(lds + 131072);
    for (int i = tid; i < 3 * 1024; i += 512) { const int c = i >> 10, k = i & 1023; const float v = (c == 0) ? inptr(I_CCTX)[k] : inptr(I_C)[(c - 1) * 1024 + k]; SC[i] = silu_f(v); }
    __syncthreads();
    float* scr = (float*)(lds + wave * 16384);
    float* MODP = (float*)(a.ws + WS_MODP);
    constexpr int N_ADA = 2304, N_FOLD = 1024, N_TRL = 10112, N_TR = 2 * N_TRL, NIT = N_ADA + N_FOLD + N_TR;
    for (int it = gw; it < NIT; it += NGW) {
        if (it < N_ADA) {
            const int l = it / 1152, r2 = it % 1152, cb = r2 >> 3, kc = r2 & 7, col = cb * 64 + lane;
            const float* W = inptr(I_WADA) + (size_t)l * 1024 * NMOD + (size_t)(kc * 128) * NMOD + col;
            const float* s0 = SC + kc * 128;
            float a0 = 0.f, a1 = 0.f, a2 = 0.f;
#pragma unroll 32
            for (int k = 0; k < 128; ++k) { const float w = W[(size_t)k * NMOD]; a0 += s0[k] * w; a1 += s0[1024 + k] * w; a2 += s0[2048 + k] * w; }
            float* o = MODP + (size_t)((l * 8 + kc) * 3) * NMOD + col;
            o[0] = a0; o[NMOD] = a1; o[2 * NMOD] = a2;
        } else if (it < N_ADA + N_FOLD) {
            const int r = it - N_ADA, l = r >> 9, r2 = r & 511, kg = r2 >> 4, nb = r2 & 15, k0 = kg * 8, n = nb * 64 + lane;
            const float* pw = inptr(I_CPW) + (size_t)l * 65536 + (size_t)k0 * 256;
            const float* wm = inptr(I_WMO) + (size_t)l * 1048576 + (size_t)512 * 1024 + n;
            float acc[8];
#pragma unroll
            for (int q = 0; q < 8; ++q) acc[q] = 0.f;
#pragma unroll 16
            for (int j = 0; j < 256; ++j) { const float wv = wm[(size_t)j * 1024];
#pragma unroll
                for (int q = 0; q < 8; ++q) acc[q] += pw[q * 256 + j] * wv; }
            bf16_t* WT = (bf16_t*)(a.ws + WS_W + l * WL + WO_MO);
            u32x4 o; o.x = pk2(acc[0], acc[1]); o.y = pk2(acc[2], acc[3]); o.z = pk2(acc[4], acc[5]); o.w = pk2(acc[6], acc[7]);
            *(u32x4*)(WT + (size_t)n * 1024 + 512 + k0) = o;
        } else {
            int r = it - N_ADA - N_FOLD; const int l = r / N_TRL; r %= N_TRL;
            unsigned char* wl = a.ws + WS_W + l * WL;
            if (r < 8448) {
                const int which = r / 1408, q = r % 1408;
                const int ffn = which / 3, kind = which % 3;
                const float* W = inptr((ffn ? I_F2G : I_F1G) + kind) + (size_t)l * 1024 * DFF;
                if (kind < 2) { const int kb = q / 88, nb = q % 88, n0 = nb * 32;
                    tr_item(W, DFF, (bf16_t*)(wl + (ffn ? WO_GU2 : WO_GU1)), 1024, kb * 64, n0, (n0 >> 7) * 256 + (n0 & 127) + kind * 128, scr, lane); }
                else { const int kb = q / 32, nb = q % 32;
                    tr_item(W, 1024, (bf16_t*)(wl + (ffn ? WO_D2 : WO_D1)), DFF, kb * 64, nb * 32, nb * 32, scr, lane); }
            } else if (r < 8448 + 1280) { const int q = r - 8448, kb = q / 80, nb = q % 80;
                tr_item(inptr(I_WMI) + (size_t)l * 1024 * MIXIN, MIXIN, (bf16_t*)(wl + WO_MI), 1024, kb * 64, nb * 32, nb * 32, scr, lane);
            } else { const int q = r - 9728, kbi = q / 32, nb = q % 32, kb = kbi < 8 ? kbi : kbi + 4;
                tr_item(inptr(I_WMO) + (size_t)l * 1048576, 1024, (bf16_t*)(wl + WO_MO), 1024, kb * 64, nb * 32, nb * 32, scr, lane);
            }
        }
    }
}

__device__ __forceinline__ void mod_finalize(const Args& a, int vcu, int G) {
    const int tid = tid_now();
    const float* MODP = (const float*)(a.ws + WS_MODP); float* TAB = (float*)(a.ws + WS_TAB);
    const float* bada = inptr(I_BADA); const float* npost = inptr(I_NPOST); const float* npre = inptr(I_NPRE);
    for (int idx = vcu * 512 + tid; idx < 2 * 27 * 1024; idx += G * 512) {
        const int j = idx & 1023; int t = idx >> 10; const int c = t % 3; t /= 3; const int kind = t % 3; t /= 3; const int i = t % 3, l = t / 3;
        const int mi = kind == 0 ? 3 * i + 2 : (kind == 1 ? 3 * i + 1 : 3 * i);
        float v = bada[(size_t)l * NMOD + mi * 1024 + j];
#pragma unroll
        for (int kc = 0; kc < 8; ++kc) v += MODP[(size_t)((l * 8 + kc) * 3 + c) * NMOD + mi * 1024 + j];
        const float gs = (i == 1) ? 1.0f : 0.5f;
        TAB[idx] = kind == 0 ? gs * v * npost[(l * 3 + i) * 1024 + j] : (kind == 1 ? (1.0f + v) * npre[(l * 3 + i) * 1024 + j] : v);
    }
}

__device__ __forceinline__ void norm_phase(const Args& a, unsigned char* lds, int vcu, int NGW,
                                           bool first, bool has_prev, int lp, int ip, bool has_next, int ln, int in_, bool dry = false) {
    const int tid = tid_now(), lane = tid & 63, wave = __builtin_amdgcn_readfirstlane(tid >> 6), gw = vcu * 8 + wave;
    float* MV = (float*)lds;
    const float* TAB = (const float*)(a.ws + WS_TAB);
    __syncthreads();
    for (int idx = tid * 4; idx < 9216; idx += 2048) {
        const int kind = idx / 3072, rem = idx % 3072;
        const int l = kind == 0 ? lp : ln, i = kind == 0 ? ip : in_;
        f32x4 v = (f32x4){0.f, 0.f, 0.f, 0.f};
        if (kind == 0 ? has_prev : has_next) v = *(const f32x4*)(TAB + (size_t)(((l * 3 + i) * 3 + kind) * 3) * 1024 + rem);
        *(f32x4*)(MV + idx) = v;
    }
    __syncthreads();
    float* X = a.out; float* XO = dry ? (float*)(a.ws + WS_ACT) : a.out;
    const bf16_t* Y0 = (const bf16_t*)(a.ws + WS_Y); const bf16_t* Y1 = Y0 + (size_t)TOK * D;
    bf16_t* H = (bf16_t*)(a.ws + (dry ? WS_CAT : WS_H));
    const float* xp = inptr(I_XP); const float* xsm = inptr(I_XS);
    constexpr int R = 4;
    const int co = 8 * lane;
    for (int r0 = gw; r0 < TOK; r0 += R * NGW) {
        f32x4 x[R][4]; u32x4 ya[R][2], yb[R][2];
#pragma unroll
        for (int rr = 0; rr < R; ++rr) { const int row = r0 + rr * NGW;
            if (row < TOK) {
                const float* xs = first ? (row < CTX_TOK ? xp + (size_t)row * D : xsm + (size_t)(row - CTX_TOK) * D) : X + (size_t)row * D;
#pragma unroll
                for (int j = 0; j < 2; ++j) { x[rr][2 * j] = *(const f32x4*)(xs + co + 512 * j); x[rr][2 * j + 1] = *(const f32x4*)(xs + co + 512 * j + 4); }
                if (has_prev) {
#pragma unroll
                    for (int j = 0; j < 2; ++j) { ya[rr][j] = *(const u32x4*)(Y0 + (size_t)row * D + co + 512 * j); yb[rr][j] = *(const u32x4*)(Y1 + (size_t)row * D + co + 512 * j); }
                }
            } }
#pragma unroll
        for (int rr = 0; rr < R; ++rr) { const int row = r0 + rr * NGW;
            if (row < TOK) {
                const int c = row < CTX_TOK ? 0 : (row < CTX_TOK + SEQ_L ? 1 : 2);
                if (has_prev) {
                    f32x4 y[4]; float s = 0.f;
#pragma unroll
                    for (int j = 0; j < 2; ++j) {
#pragma unroll
                        for (int q = 0; q < 4; ++q) { const unsigned wa = ya[rr][j][q], wb = yb[rr][j][q];
                            const float lo = __builtin_bit_cast(float, wa << 16) + __builtin_bit_cast(float, wb << 16);
                            const float hi = __builtin_bit_cast(float, wa & 0xffff0000u) + __builtin_bit_cast(float, wb & 0xffff0000u);
                            y[2 * j + (q >> 1)][2 * (q & 1)] = lo; y[2 * j + (q >> 1)][2 * (q & 1) + 1] = hi; s += lo * lo + hi * hi; } }
                    const float ry = rsqrtf(wave_sum(s) * (1.0f / D) + EPS);
#pragma unroll
                    for (int j = 0; j < 2; ++j)
#pragma unroll
                        for (int h2 = 0; h2 < 2; ++h2) { const f32x4 gp = *(const f32x4*)(MV + c * 1024 + co + 512 * j + 4 * h2); x[rr][2 * j + h2] = x[rr][2 * j + h2] + gp * y[2 * j + h2] * ry; }
                }
                if (has_prev) {
#pragma unroll
                    for (int j = 0; j < 2; ++j) { *(f32x4*)(XO + (size_t)row * D + co + 512 * j) = x[rr][2 * j]; *(f32x4*)(XO + (size_t)row * D + co + 512 * j + 4) = x[rr][2 * j + 1]; }
                }
                if (has_next) {
                    float s = 0.f;
#pragma unroll
                    for (int q = 0; q < 4; ++q) s += (x[rr][q][0] * x[rr][q][0] + x[rr][q][1] * x[rr][q][1]) + (x[rr][q][2] * x[rr][q][2] + x[rr][q][3] * x[rr][q][3]);
                    const float rx = rsqrtf(wave_sum(s) * (1.0f / D) + EPS);
#pragma unroll
                    for (int j = 0; j < 2; ++j) {
                        const f32x4 a0 = *(const f32x4*)(MV + 3072 + c * 1024 + co + 512 * j), a1 = *(const f32x4*)(MV + 3072 + c * 1024 + co + 512 * j + 4);
                        const f32x4 s0 = *(const f32x4*)(MV + 6144 + c * 1024 + co + 512 * j), s1 = *(const f32x4*)(MV + 6144 + c * 1024 + co + 512 * j + 4);
                        const f32x4 h0 = x[rr][2 * j] * rx * a0 + s0, h1 = x[rr][2 * j + 1] * rx * a1 + s1;
                        u32x4 w; w.x = pg8::cvt_pk_bf16(h0[0], h0[1]); w.y = pg8::cvt_pk_bf16(h0[2], h0[3]); w.z = pg8::cvt_pk_bf16(h1[0], h1[1]); w.w = pg8::cvt_pk_bf16(h1[2], h1[3]);
                        *(u32x4*)(H + (size_t)row * D + co + 512 * j) = w; }
                }
            } }
    }
}

__device__ __forceinline__ void rope_pair(float& x, float xp, float ang, bool second) {
    const float s = __sinf(ang), c = __cosf(ang);
    x = second ? (xp * s + x * c) : (x * c - xp * s);
}
__device__ __forceinline__ float bflo(unsigned w) { return __builtin_bit_cast(float, w << 16); }
__device__ __forceinline__ float bfhi(unsigned w) { return __builtin_bit_cast(float, w & 0xffff0000u); }
__device__ __forceinline__ void mix_prep(const Args& a, unsigned char* lds, int l) {
    const int tid = tid_now(), lane = tid & 63, wave = __builtin_amdgcn_readfirstlane(tid >> 6);
    const bf16_t* PROJ = (const bf16_t*)(a.ws + WS_ACT);
    bf16_t* CAT = (bf16_t*)(a.ws + WS_CAT);
    bf16_t* QD = (bf16_t*)(a.ws + WS_QD); bf16_t* QG = (bf16_t*)(a.ws + WS_QG);
    float* U = (float*)lds;
    float* VB = (float*)(lds + 65536);
    const float qs_d = 0.17677669529663687f * LOG2E, qs_g = 0.125f * LOG2E;
    const float L2T = 13.287712379549449f;
    float invd[4], invg[4], invk[2];
#pragma unroll
    for (int t = 0; t < 4; ++t) { invd[t] = exp2f(-(float)(4 * (lane & 1) + t) * (L2T / 8.0f)); invg[t] = exp2f(-(float)(4 * (lane & 3) + t) * (L2T / 16.0f)); }
#pragma unroll
    for (int t = 0; t < 2; ++t) invk[t] = exp2f(-(float)(2 * (lane & 7) + t) * (L2T / 16.0f));
    for (int tile = blockIdx.x; tile < TOK / 32; tile += gridDim.x) {
        const int row0 = tile * 32; const bool lat = row0 >= CTX_TOK;
        int seq, pos0, seqlen;
        if (!lat) { seq = row0 / SEQ_C; pos0 = row0 % SEQ_C; seqlen = SEQ_C; } else { seq = (row0 - CTX_TOK) / SEQ_L; pos0 = (row0 - CTX_TOK) % SEQ_L; seqlen = SEQ_L; }
        bf16_t* KD = lat ? (bf16_t*)(a.ws + WS_KDL) + (size_t)(seq * S_LAT + 256) * 256 : (bf16_t*)(a.ws + WS_KDC) + (size_t)(seq * SEQ_C) * 256;
        bf16_t* VD = lat ? (bf16_t*)(a.ws + WS_VDL) + (size_t)(seq * S_LAT + 256) * 256 : (bf16_t*)(a.ws + WS_VDC) + (size_t)(seq * SEQ_C) * 256;
        bf16_t* KG = lat ? (bf16_t*)(a.ws + WS_KGL) + (size_t)(seq * S_LAT + 256) * 128 : (bf16_t*)(a.ws + WS_KGC) + (size_t)(seq * SEQ_C) * 128;
        bf16_t* VG = lat ? (bf16_t*)(a.ws + WS_VGL) + (size_t)(seq * S_LAT + 256) * 128 : (bf16_t*)(a.ws + WS_VGC) + (size_t)(seq * SEQ_C) * 128;
#pragma unroll 1
        for (int hh = 0; hh < 2; ++hh) {
            const int row_b = row0 + wave * 4 + hh * 2, pos_b = pos0 + wave * 4 + hh * 2;
            u32x2 dq[2], dk[2], dv[2], gqp[2][4], ab[2], ac[4], ah[4]; unsigned gkp[2][4], gvp[2][4];
#pragma unroll
            for (int rr = 0; rr < 2; ++rr) { const bf16_t* pr = PROJ + (size_t)(row_b + rr) * MIXIN;
                dq[rr] = *(const u32x2*)(pr + 768 + 4 * lane); dk[rr] = *(const u32x2*)(pr + 1024 + 4 * lane); dv[rr] = *(const u32x2*)(pr + 1280 + 4 * lane);
                ab[rr] = *(const u32x2*)(pr + 4 * lane); }
#pragma unroll
            for (int t = 0; t < 4; ++t) { const int tp = pos_b - 1 + t; const bool valid = tp >= 0 && tp < seqlen; const bf16_t* pr = PROJ + (size_t)(row_b - 1 + t) * MIXIN;
                ac[t] = (u32x2){0u, 0u}; ah[t] = (u32x2){0u, 0u};
                if (valid) { ac[t] = *(const u32x2*)(pr + 256 + 4 * lane); ah[t] = *(const u32x2*)(pr + 512 + 4 * lane); } }
#pragma unroll
            for (int rr = 0; rr < 2; ++rr) { const int row = row_b + rr, pos = pos_b + rr;
                float q[4] = {bflo(dq[rr].x), bfhi(dq[rr].x), bflo(dq[rr].y), bfhi(dq[rr].y)};
                float k[4] = {bflo(dk[rr].x), bfhi(dk[rr].x), bflo(dk[rr].y), bfhi(dk[rr].y)};
                if (lat) {
                    const float pax = (float)((lane & 4) ? (pos & 63) : (pos >> 6)); const bool second = (lane & 2) != 0;
#pragma unroll
                    for (int t = 0; t < 4; ++t) { const float ang = pax * invd[t]; const float sn = __sinf(ang), cs = __cosf(ang);
                        const float qp = __shfl_xor(q[t], 2), kp = __shfl_xor(k[t], 2);
                        q[t] = second ? (qp * sn + q[t] * cs) : (q[t] * cs - qp * sn); k[t] = second ? (kp * sn + k[t] * cs) : (k[t] * cs - kp * sn); }
                } else {
                    float* odk = a.out + 8388608 + ((size_t)(seq * 2 + l) * 256 + pos) * 256 + 4 * lane;
                    float* odv = a.out + 10485760 + ((size_t)(seq * 2 + l) * 256 + pos) * 256 + 4 * lane;
                    *(f32x4*)odk = (f32x4){k[0], k[1], k[2], k[3]};
                    *(f32x4*)odv = (f32x4){bflo(dv[rr].x), bfhi(dv[rr].x), bflo(dv[rr].y), bfhi(dv[rr].y)};
                }
                u32x2 w; w.x = pg8::cvt_pk_bf16(q[0] * qs_d, q[1] * qs_d); w.y = pg8::cvt_pk_bf16(q[2] * qs_d, q[3] * qs_d);
                *(u32x2*)(QD + (size_t)row * 256 + 4 * lane) = w;
                w.x = pg8::cvt_pk_bf16(k[0], k[1]); w.y = pg8::cvt_pk_bf16(k[2], k[3]);
                *(u32x2*)(KD + (size_t)pos * 256 + 4 * lane) = w;
                *(u32x2*)(VD + (size_t)pos * 256 + 4 * lane) = dv[rr];
            }
            asm volatile("" ::: "memory");
            const bf16_t* PART = (const bf16_t*)(a.ws + WS_Y);
#pragma unroll
            for (int rr = 0; rr < 2; ++rr)
#pragma unroll
                for (int ks = 0; ks < 4; ++ks) { const bf16_t* pp = PART + ((size_t)ks * TOK + row_b + rr) * 512;
                    gqp[rr][ks] = *(const u32x2*)(pp + 4 * lane); gkp[rr][ks] = *(const unsigned*)(pp + 256 + 2 * lane); gvp[rr][ks] = *(const unsigned*)(pp + 384 + 2 * lane); }
            const f32x4 qnv = *(const f32x4*)(inptr(I_QNORM) + l * 64 + 4 * (lane & 15));
#pragma unroll
            for (int rr = 0; rr < 2; ++rr) { const int row = row_b + rr, pos = pos_b + rr;
                float q[4] = {0.f, 0.f, 0.f, 0.f};
#pragma unroll
                for (int ks = 0; ks < 4; ++ks) { q[0] += bflo(gqp[rr][ks].x); q[1] += bfhi(gqp[rr][ks].x); q[2] += bflo(gqp[rr][ks].y); q[3] += bfhi(gqp[rr][ks].y); }
                float ss = (q[0] * q[0] + q[1] * q[1]) + (q[2] * q[2] + q[3] * q[3]);
                ss += __shfl_xor(ss, 1); ss += __shfl_xor(ss, 2); ss += __shfl_xor(ss, 4); ss += __shfl_xor(ss, 8);
                const float rn = rsqrtf(ss * (1.0f / 64.0f) + EPS);
#pragma unroll
                for (int t = 0; t < 4; ++t) q[t] = q[t] * rn * qnv[t];
                if (lat) {
                    const float pax = (float)((lane & 8) ? (pos & 63) : (pos >> 6)); const bool second = (lane & 4) != 0;
#pragma unroll
                    for (int t = 0; t < 4; ++t) { const float ang = pax * invg[t]; const float sn = __sinf(ang), cs = __cosf(ang);
                        const float qp = __shfl_xor(q[t], 4);
                        q[t] = second ? (qp * sn + q[t] * cs) : (q[t] * cs - qp * sn); }
                }
                u32x2 w; w.x = pg8::cvt_pk_bf16(q[0] * qs_g, q[1] * qs_g); w.y = pg8::cvt_pk_bf16(q[2] * qs_g, q[3] * qs_g);
                *(u32x2*)(QG + (size_t)row * 256 + 4 * lane) = w;
            }
            const float kn0 = inptr(I_KNORM)[l * 64 + 2 * (lane & 31)], kn1 = inptr(I_KNORM)[l * 64 + 2 * (lane & 31) + 1];
#pragma unroll
            for (int rr = 0; rr < 2; ++rr) { const int pos = pos_b + rr;
                float k0 = 0.f, k1 = 0.f, v0 = 0.f, v1 = 0.f;
#pragma unroll
                for (int ks = 0; ks < 4; ++ks) { k0 += bflo(gkp[rr][ks]); k1 += bfhi(gkp[rr][ks]); v0 += bflo(gvp[rr][ks]); v1 += bfhi(gvp[rr][ks]); }
                const unsigned vpk = pg8::cvt_pk_bf16(v0, v1);
                float ss = k0 * k0 + k1 * k1;
                ss += __shfl_xor(ss, 1); ss += __shfl_xor(ss, 2); ss += __shfl_xor(ss, 4); ss += __shfl_xor(ss, 8); ss += __shfl_xor(ss, 16);
                const float rn = rsqrtf(ss * (1.0f / 64.0f) + EPS);
                k0 = k0 * rn * kn0; k1 = k1 * rn * kn1;
                if (lat) {
                    const float pax = (float)((lane & 16) ? (pos & 63) : (pos >> 6)); const bool second = (lane & 8) != 0;
                    const float a0 = pax * invk[0], a1 = pax * invk[1];
                    const float s0 = __sinf(a0), c0 = __cosf(a0), s1 = __sinf(a1), c1 = __cosf(a1);
                    const float p0 = __shfl_xor(k0, 8), p1 = __shfl_xor(k1, 8);
                    k0 = second ? (p0 * s0 + k0 * c0) : (k0 * c0 - p0 * s0); k1 = second ? (p1 * s1 + k1 * c1) : (k1 * c1 - p1 * s1);
                } else {
                    float* ogk = a.out + 12582912 + ((size_t)(seq * 2 + l) * 256 + pos) * 128 + 2 * lane;
                    float* ogv = a.out + 13631488 + ((size_t)(seq * 2 + l) * 256 + pos) * 128 + 2 * lane;
                    typedef float f32x2 __attribute__((ext_vector_type(2)));
                    *(f32x2*)ogk = (f32x2){k0, k1}; *(f32x2*)ogv = (f32x2){bflo(vpk), bfhi(vpk)};
                }
                *(unsigned*)(KG + (size_t)pos * 128 + 2 * lane) = pg8::cvt_pk_bf16(k0, k1);
                *(unsigned*)(VG + (size_t)pos * 128 + 2 * lane) = vpk;
            }
            {
                f32x4 scw[3];
#pragma unroll
                for (int k = 0; k < 3; ++k) scw[k] = *(const f32x4*)(inptr(I_SCW) + (l * 3 + k) * 256 + 4 * lane);
                float pr6[4][4];
#pragma unroll
                for (int t = 0; t < 4; ++t) { pr6[t][0] = bflo(ac[t].x) * bflo(ah[t].x); pr6[t][1] = bfhi(ac[t].x) * bfhi(ah[t].x); pr6[t][2] = bflo(ac[t].y) * bflo(ah[t].y); pr6[t][3] = bfhi(ac[t].y) * bfhi(ah[t].y); }
#pragma unroll
                for (int rr = 0; rr < 2; ++rr) {
                    float o[4]; const float b4[4] = {bflo(ab[rr].x), bfhi(ab[rr].x), bflo(ab[rr].y), bfhi(ab[rr].y)};
#pragma unroll
                    for (int e = 0; e < 4; ++e) o[e] = b4[e] * (scw[0][e] * pr6[rr][e] + scw[1][e] * pr6[rr + 1][e] + scw[2][e] * pr6[rr + 2][e]);
                    u32x2 w; w.x = pg8::cvt_pk_bf16(o[0], o[1]); w.y = pg8::cvt_pk_bf16(o[2], o[3]);
                    *(u32x2*)(CAT + (size_t)(row_b + rr) * D + 4 * lane) = w;
                }
            }
        }
        if (wave < 2) {
            const int id = tile * 2 + wave, b = id >> 8, p = id & 255;
            const size_t src = ((size_t)(b * 2 + l) * 256 + p);
            typedef float f32x2 __attribute__((ext_vector_type(2)));
            const f32x4 ck = *(const f32x4*)(inptr(I_CDK) + src * 256 + 4 * lane), cv = *(const f32x4*)(inptr(I_CDV) + src * 256 + 4 * lane);
            const f32x2 gkk = *(const f32x2*)(inptr(I_CGK) + src * 128 + 2 * lane), gvv = *(const f32x2*)(inptr(I_CGV) + src * 128 + 2 * lane);
            u32x2 w; w.x = pg8::cvt_pk_bf16(ck[0], ck[1]); w.y = pg8::cvt_pk_bf16(ck[2], ck[3]);
            *(u32x2*)((bf16_t*)(a.ws + WS_KDL) + (size_t)(b * S_LAT + p) * 256 + 4 * lane) = w;
            w.x = pg8::cvt_pk_bf16(cv[0], cv[1]); w.y = pg8::cvt_pk_bf16(cv[2], cv[3]);
            *(u32x2*)((bf16_t*)(a.ws + WS_VDL) + (size_t)(b * S_LAT + p) * 256 + 4 * lane) = w;
            *(unsigned*)((bf16_t*)(a.ws + WS_KGL) + (size_t)(b * S_LAT + p) * 128 + 2 * lane) = pg8::cvt_pk_bf16(gkk[0], gkk[1]);
            *(unsigned*)((bf16_t*)(a.ws + WS_VGL) + (size_t)(b * S_LAT + p) * 128 + 2 * lane) = pg8::cvt_pk_bf16(gvv[0], gvv[1]);
        }
        __syncthreads();
        {
            const int cp = tid & 127, rg = tid >> 7;
            unsigned ca[16], cgv[16];
#pragma unroll
            for (int i = 0; i < 16; ++i) { const int r = rg + 4 * i, tp = pos0 - 15 + r; ca[i] = 0u; cgv[i] = 0u;
                if (r < 62 && tp >= 0 && tp < seqlen) { const bf16_t* p2 = PROJ + (size_t)(row0 - 15 + r) * MIXIN; ca[i] = *(const unsigned*)(p2 + 1536 + 2 * cp); cgv[i] = *(const unsigned*)(p2 + 1792 + 2 * cp); } }
#pragma unroll
            for (int i = 0; i < 16; ++i) { const int r = rg + 4 * i;
                if (r < 62) { typedef float f32x2 __attribute__((ext_vector_type(2)));
                    const float u0 = bflo(ca[i]) * __builtin_amdgcn_rcpf(1.0f + __builtin_amdgcn_exp2f(-LOG2E * bflo(cgv[i]))), u1 = bfhi(ca[i]) * __builtin_amdgcn_rcpf(1.0f + __builtin_amdgcn_exp2f(-LOG2E * bfhi(cgv[i])));
                    *(f32x2*)(U + r * 256 + 2 * cp) = (f32x2){u0, u1}; } }
        }
        __syncthreads();
        {
            const int c = tid & 255, half = tid >> 8;
            float w[31], acc[16];
#pragma unroll
            for (int k = 0; k < 31; ++k) w[k] = inptr(I_CDWW)[(l * 31 + k) * 256 + c];
            const float bias = inptr(I_CDWB)[l * 256 + c];
#pragma unroll
            for (int o = 0; o < 16; ++o) acc[o] = bias;
#pragma unroll
            for (int i = 0; i < 46; ++i) { const float u = U[(16 * half + i) * 256 + c];
#pragma unroll
                for (int o = 0; o < 16; ++o) { const int k = i - o; if (k >= 0 && k < 31) acc[o] += w[k] * u; } }
#pragma unroll
            for (int o = 0; o < 16; ++o) VB[(16 * half + o) * 256 + c] = acc[o];
        }
        __syncthreads();
        const f32x4 lng = *(const f32x4*)(inptr(I_CLNG) + l * 256 + 4 * lane), lnb = *(const f32x4*)(inptr(I_CLNB) + l * 256 + 4 * lane);
#pragma unroll
        for (int rr = 0; rr < 4; ++rr) {
            const int rl = wave * 4 + rr, row = row0 + rl;
            f32x4 v = *(const f32x4*)(VB + rl * 256 + 4 * lane);
            const float mu = wave_sum((v[0] + v[1]) + (v[2] + v[3])) * (1.0f / 256.0f);
            v = v - mu;
            const float rstd = rsqrtf(wave_sum((v[0] * v[0] + v[1] * v[1]) + (v[2] * v[2] + v[3] * v[3])) * (1.0f / 256.0f) + EPS);
            const f32x4 y = v * rstd * lng + lnb;
            u32x2 w; w.x = pg8::cvt_pk_bf16(silu_f(y[0]), silu_f(y[1])); w.y = pg8::cvt_pk_bf16(silu_f(y[2]), silu_f(y[3]));
            *(u32x2*)(CAT + (size_t)row * D + 512 + 4 * lane) = w;
        }
        __syncthreads();
    }
}

constexpr int AT_KB = 64 * 144;
constexpr int AT_K0 = 0, AT_V0 = 2 * AT_KB, AT_XCH = 40960;
template <int DK>
__device__ __forceinline__ void attn_unit(unsigned char* lds, const Args& a, int l, bool is_diff, int hidx, int qrow0, const bf16_t* Kp, const bf16_t* Vp, int ldkv, int S) {
    const int tid = tid_now(), lane = tid & 63, wave = __builtin_amdgcn_readfirstlane(tid >> 6), sub = wave >> 2, wq = wave & 3, r32 = lane & 31, hi = lane >> 5;
    const int kcol = hidx * 64;
    const int kcsub = is_diff ? sub * 32 : 0;
    const bf16_t* Qp = is_diff ? (const bf16_t*)(a.ws + WS_QD) + hidx * 64 + sub * 32 : (const bf16_t*)(a.ws + WS_QG) + (2 * hidx + sub) * 64;
    const int qrow = qrow0 + wq * 32 + r32;
    bf16x8 qf[DK / 16];
#pragma unroll
    for (int d0 = 0; d0 < DK / 16; ++d0) qf[d0] = *(const bf16x8*)(Qp + (size_t)qrow * 256 + d0 * 16 + hi * 8);
    const int sr = tid & 63, sch = tid >> 6;
    const bf16_t* kg = Kp + (size_t)sr * ldkv + kcol + sch * 8; const bf16_t* vg = Vp + (size_t)sr * ldkv + kcol + sch * 8;
    const int o16 = sr & 15; const int vcol = 16 * (sr >> 4) + 8 * ((o16 >> 2) & 1) + (o16 & 3) + 4 * (o16 >> 3);
    u32x4 kreg = *(const u32x4*)kg, vreg = *(const u32x4*)vg;
    const int NT = S / 64;
    float m_run = 0.f, l_run = 0.f;
    f32x16 o0, o1;
#pragma unroll
    for (int r = 0; r < 16; ++r) { o0[r] = 0.f; o1[r] = 0.f; }
    for (int t = 0; t < NT; ++t) {
        unsigned char* kb = lds + AT_K0 + (t & 1) * AT_KB; unsigned char* vb = lds + AT_V0 + (t & 1) * AT_KB;
        *(u32x4*)(kb + sr * 144 + sch * 16) = kreg;
        {
            bf16_t* vt = (bf16_t*)vb + (sch * 8) * 72 + vcol;
            vt[0 * 72] = (bf16_t)(vreg.x & 0xffffu); vt[1 * 72] = (bf16_t)(vreg.x >> 16); vt[2 * 72] = (bf16_t)(vreg.y & 0xffffu); vt[3 * 72] = (bf16_t)(vreg.y >> 16);
            vt[4 * 72] = (bf16_t)(vreg.z & 0xffffu); vt[5 * 72] = (bf16_t)(vreg.z >> 16); vt[6 * 72] = (bf16_t)(vreg.w & 0xffffu); vt[7 * 72] = (bf16_t)(vreg.w >> 16);
        }
        __syncthreads();
        if (t + 1 < NT) { kreg = *(const u32x4*)(kg + (size_t)(t + 1) * 64 * ldkv); vreg = *(const u32x4*)(vg + (size_t)(t + 1) * 64 * ldkv); }
        f32x16 p0, p1;
        { const float nm = -m_run;
#pragma unroll
        for (int r = 0; r < 16; ++r) { p0[r] = nm; p1[r] = nm; } }
#pragma unroll
        for (int d0 = 0; d0 < DK / 16; ++d0) {
            const bf16x8 k0 = *(const bf16x8*)(kb + r32 * 144 + (kcsub + 16 * d0 + 8 * hi) * 2);
            const bf16x8 k1 = *(const bf16x8*)(kb + (32 + r32) * 144 + (kcsub + 16 * d0 + 8 * hi) * 2);
            p0 = __builtin_amdgcn_mfma_f32_32x32x16_bf16(k0, qf[d0], p0, 0, 0, 0);
            p1 = __builtin_amdgcn_mfma_f32_32x32x16_bf16(k1, qf[d0], p1, 0, 0, 0);
        }
        float mxa = fmaxf(fmaxf(p0[0], p0[1]), p1[0]), mxb = fmaxf(fmaxf(p0[2], p0[3]), p1[1]);
        mxa = fmaxf(fmaxf(mxa, p1[2]), p1[3]);
#pragma unroll
        for (int r = 4; r < 16; r += 4) { mxa = fmaxf(fmaxf(mxa, p0[r]), p0[r + 1]); mxb = fmaxf(fmaxf(mxb, p0[r + 2]), p0[r + 3]); mxa = fmaxf(fmaxf(mxa, p1[r]), p1[r + 1]); mxb = fmaxf(fmaxf(mxb, p1[r + 2]), p1[r + 3]); }
        float mx = fmaxf(mxa, mxb);
        mx = fmaxf(mx, __shfl_xor(mx, 32));
        if (__any(mx > 0.f)) {
            const float dl = fmaxf(mx, 0.f); m_run += dl;
            const float alpha = __builtin_amdgcn_exp2f(-dl); l_run *= alpha;
#pragma unroll
            for (int r = 0; r < 16; ++r) { p0[r] -= dl; p1[r] -= dl; o0[r] *= alpha; o1[r] *= alpha; }
        }
        float ls = 0.f;
#pragma unroll
        for (int r = 0; r < 16; ++r) { p0[r] = __builtin_amdgcn_exp2f(p0[r]); p1[r] = __builtin_amdgcn_exp2f(p1[r]); ls += p0[r] + p1[r]; }
        l_run += ls;
        bf16x8 pk[4];
#pragma unroll
        for (int ks = 0; ks < 4; ++ks) {
            u32x4 w;
            if (ks < 2) { w.x = pg8::cvt_pk_bf16(p0[8 * ks + 0], p0[8 * ks + 1]); w.y = pg8::cvt_pk_bf16(p0[8 * ks + 2], p0[8 * ks + 3]); w.z = pg8::cvt_pk_bf16(p0[8 * ks + 4], p0[8 * ks + 5]); w.w = pg8::cvt_pk_bf16(p0[8 * ks + 6], p0[8 * ks + 7]); }
            else { const int b = 8 * (ks - 2); w.x = pg8::cvt_pk_bf16(p1[b + 0], p1[b + 1]); w.y = pg8::cvt_pk_bf16(p1[b + 2], p1[b + 3]); w.z = pg8::cvt_pk_bf16(p1[b + 4], p1[b + 5]); w.w = pg8::cvt_pk_bf16(p1[b + 6], p1[b + 7]); }
            pk[ks] = __builtin_bit_cast(bf16x8, w);
        }
#pragma unroll
        for (int ks = 0; ks < 4; ++ks) {
            const bf16x8 v0 = *(const bf16x8*)(vb + r32 * 144 + (16 * ks + 8 * hi) * 2);
            const bf16x8 v1 = *(const bf16x8*)(vb + (32 + r32) * 144 + (16 * ks + 8 * hi) * 2);
            o0 = __builtin_amdgcn_mfma_f32_32x32x16_bf16(v0, pk[ks], o0, 0, 0, 0);
            o1 = __builtin_amdgcn_mfma_f32_32x32x16_bf16(v1, pk[ks], o1, 0, 0, 0);
        }
    }
    const float lt = l_run + __shfl_xor(l_run, 32); const float inv = 1.0f / lt;
#pragma unroll
    for (int r = 0; r < 16; ++r) { o0[r] *= inv; o1[r] *= inv; }
    bf16_t* CAT = (bf16_t*)(a.ws + WS_CAT);
    if (is_diff) {
        float* XCH = (float*)(lds + AT_XCH);
        if (sub == 1) {
#pragma unroll
            for (int r = 0; r < 16; ++r) { XCH[(wq * 32 + r) * 64 + lane] = o0[r]; XCH[(wq * 32 + 16 + r) * 64 + lane] = o1[r]; }
        }
        __syncthreads();
        if (sub == 0) {
            float d1 = (lane < 32) ? inptr(I_LQ1)[l * 32 + lane] * inptr(I_LK1)[l * 32 + lane] : 0.f;
            float d2 = (lane < 32) ? inptr(I_LQ2)[l * 32 + lane] * inptr(I_LK2)[l * 32 + lane] : 0.f;
            const float lam_init = (l == 0) ? 0.2f : 0.35550907f;
            const float lam = __expf(wave_sum(d1)) - __expf(wave_sum(d2)) + lam_init;
            float ss = 0.f;
#pragma unroll
            for (int r = 0; r < 16; ++r) { o0[r] -= lam * XCH[(wq * 32 + r) * 64 + lane]; o1[r] -= lam * XCH[(wq * 32 + 16 + r) * 64 + lane]; ss += o0[r] * o0[r] + o1[r] * o1[r]; }
            ss += __shfl_xor(ss, 32);
            const float rs = rsqrtf(ss * (1.0f / 64.0f) + EPS) * (1.0f - lam_init);
            bf16_t* op = CAT + (size_t)qrow * D + 256 + hidx * 64;
#pragma unroll
            for (int g = 0; g < 4; ++g) {
                const int d = 8 * g + 4 * hi; const float* sl = inptr(I_SUBLN) + l * 64;
                u32x2 w0, w1;
                w0.x = pk2(o0[4 * g + 0] * rs * sl[d + 0], o0[4 * g + 1] * rs * sl[d + 1]); w0.y = pk2(o0[4 * g + 2] * rs * sl[d + 2], o0[4 * g + 3] * rs * sl[d + 3]);
                w1.x = pk2(o1[4 * g + 0] * rs * sl[32 + d + 0], o1[4 * g + 1] * rs * sl[32 + d + 1]); w1.y = pk2(o1[4 * g + 2] * rs * sl[32 + d + 2], o1[4 * g + 3] * rs * sl[32 + d + 3]);
                *(u32x2*)(op + d) = w0; *(u32x2*)(op + 32 + d) = w1;
            }
        }
    } else {
        bf16_t* op = CAT + (size_t)qrow * D + 768 + (2 * hidx + sub) * 64;
#pragma unroll
        for (int g = 0; g < 4; ++g) {
            const int d = 8 * g + 4 * hi;
            u32x2 w0, w1;
            w0.x = pk2(o0[4 * g + 0], o0[4 * g + 1]); w0.y = pk2(o0[4 * g + 2], o0[4 * g + 3]);
            w1.x = pk2(o1[4 * g + 0], o1[4 * g + 1]); w1.y = pk2(o1[4 * g + 2], o1[4 * g + 3]);
            *(u32x2*)(op + d) = w0; *(u32x2*)(op + 32 + d) = w1;
        }
    }
    __syncthreads();
}

__device__ __forceinline__ void attn_phase(const Args& a, unsigned char* lds, int l, int rep) {
    unsigned* ctr = (unsigned*)(a.ws + WS_CTL) + 64 * (1 + l + 2 * rep);
    unsigned* slot = (unsigned*)(lds + 131072);
    for (;;) {
        __syncthreads();
        if (threadIdx.x == 0) *slot = atomicAdd(ctr, 1u);
        __syncthreads();
        const int u = (int)*slot;
        if (u >= 384) break;
        bool is_diff, lat; int seq, qb, hidx;
        if (u < 64) { lat = true; is_diff = false; seq = u / 32; const int rem = u % 32; qb = rem >> 1; hidx = rem & 1; }
        else if (u < 192) { const int v = u - 64; lat = true; is_diff = true; seq = v / 64; const int rem = v % 64; qb = rem >> 2; hidx = rem & 3; }
        else if (u < 256) { const int v = u - 192; lat = false; is_diff = false; seq = v >> 2; const int rem = v & 3; qb = rem >> 1; hidx = rem & 1; }
        else { const int v = u - 256; lat = false; is_diff = true; seq = v >> 3; const int rem = v & 7; qb = rem >> 2; hidx = rem & 3; }
        const int qrow0 = lat ? CTX_TOK + seq * SEQ_L + qb * 128 : seq * SEQ_C + qb * 128;
        const int S = lat ? S_LAT : SEQ_C;
        if (is_diff) {
            const bf16_t* Kp = lat ? (const bf16_t*)(a.ws + WS_KDL) + (size_t)seq * S_LAT * 256 : (const bf16_t*)(a.ws + WS_KDC) + (size_t)seq * SEQ_C * 256;
            const bf16_t* Vp = lat ? (const bf16_t*)(a.ws + WS_VDL) + (size_t)seq * S_LAT * 256 : (const bf16_t*)(a.ws + WS_VDC) + (size_t)seq * SEQ_C * 256;
            attn_unit<32>(lds, a, l, true, hidx, qrow0, Kp, Vp, 256, S);
        } else {
            const bf16_t* Kp = lat ? (const bf16_t*)(a.ws + WS_KGL) + (size_t)seq * S_LAT * 128 : (const bf16_t*)(a.ws + WS_KGC) + (size_t)seq * SEQ_C * 128;
            const bf16_t* Vp = lat ? (const bf16_t*)(a.ws + WS_VGL) + (size_t)seq * S_LAT * 128 : (const bf16_t*)(a.ws + WS_VGC) + (size_t)seq * SEQ_C * 128;
            attn_unit<64>(lds, a, l, false, hidx, qrow0, Kp, Vp, 128, S);
        }
    }
}

#define XB_TMO      128
#define XB_XCNT(j)  (256  + 64 * (j))
#define XB_XSUB(j)  (1280 + 64 * (j))
#define XB_XGEN(j)  (2304 + 64 * (j))
#define XB_TOP      3328
#define XB_TOPGEN   3392
#define XCD_BAR_WORDS 3456
#define XB_SPIN_CAP (1u << 18)
__device__ __forceinline__ unsigned xb_ld(unsigned* p)              { return __hip_atomic_load(p, __ATOMIC_RELAXED, __HIP_MEMORY_SCOPE_AGENT); }
__device__ __forceinline__ unsigned xb_add(unsigned* p, unsigned v) { return __hip_atomic_fetch_add(p, v, __ATOMIC_RELAXED, __HIP_MEMORY_SCOPE_AGENT); }
__device__ __forceinline__ unsigned xb_xcc_id() { return (unsigned)__builtin_amdgcn_s_getreg((3 << 11) | 20) & 0xFu; }
#define XB_SPIN(cond, bar) do { unsigned _sp = 0; while (cond) { __builtin_amdgcn_s_sleep(1); \
    if ((++_sp & 255u) == 0u) { if (xb_ld(&(bar)[XB_TMO])) break; if (_sp > XB_SPIN_CAP) { atomicAdd(&(bar)[XB_TMO], 1u); break; } } } } while (0)
struct XcdBarrier { unsigned* bar; unsigned x; volatile LAS unsigned* st; };
__device__ __forceinline__ XcdBarrier xcd_barrier_post(unsigned* bar, volatile LAS unsigned* st) {
    XcdBarrier b; b.bar = bar; b.x = xb_xcc_id(); b.st = st;
    if (threadIdx.x == 0) (void)xb_add(&bar[XB_XCNT(b.x)], 1u);
    return b;
}
__device__ __forceinline__ void xcd_barrier_complete(unsigned* bar, unsigned x, unsigned& nloc, unsigned& nx) {
    const unsigned G = gridDim.x * gridDim.y * gridDim.z;
    unsigned sum, cnt, mine, sp = 0u;
    for (;;) {
        sum = 0u; cnt = 0u; mine = 0u;
#pragma unroll 1
        for (unsigned j = 0; j < 16; ++j) { const unsigned c = xb_ld(&bar[XB_XCNT(j)]); sum += c; cnt += (c > 0u) ? 1u : 0u; mine = (j == x) ? c : mine; }
        if (sum == G) break;
        __builtin_amdgcn_s_sleep(1);
        if ((++sp & 255u) == 0u) { if (xb_ld(&bar[XB_TMO])) break; if (sp > XB_SPIN_CAP) { atomicAdd(&bar[XB_TMO], 1u); break; } }
    }
    nloc = mine > 0u ? mine : 1u; nx = cnt > 0u ? cnt : 1u;
}
__device__ __forceinline__ void xcd_barrier(const XcdBarrier& b) {
    asm volatile("s_waitcnt vmcnt(0)" ::: "memory");
    __syncthreads();
    if (threadIdx.x == 0) {
        unsigned* bar = b.bar;
        __builtin_amdgcn_s_waitcnt(0);
        unsigned nloc = b.st[0], nx = b.st[1];
        if (nloc == 0u) { xcd_barrier_complete(bar, b.x, nloc, nx); b.st[0] = nloc; b.st[1] = nx; }
        const unsigned old = xb_add(&bar[XB_XSUB(b.x)], 1u);
        const unsigned gen = old / nloc;
        if (old + 1u == (gen + 1u) * nloc) {
            __builtin_amdgcn_fence(__ATOMIC_RELEASE, "agent");
            asm volatile("s_waitcnt vmcnt(0)" ::: "memory");
            const unsigned og = xb_add(&bar[XB_TOP], 1u);
            const unsigned tg = og / nx;
            if (og + 1u == (tg + 1u) * nx) xb_add(&bar[XB_TOPGEN], 1u);
            else XB_SPIN(xb_ld(&bar[XB_TOPGEN]) == tg, bar);
            __builtin_amdgcn_fence(__ATOMIC_ACQUIRE, "agent");
            xb_add(&bar[XB_XGEN(b.x)], 1u);
            asm volatile("s_waitcnt vmcnt(0)" ::: "memory");
        } else {
            XB_SPIN(xb_ld(&bar[XB_XGEN(b.x)]) == gen, bar);
            __builtin_amdgcn_fence(__ATOMIC_ACQUIRE, "agent");
            asm volatile("s_waitcnt vmcnt(0)" ::: "memory");
        }
    }
    __syncthreads();
}

__global__ void __launch_bounds__(512, 2) fwd_kernel(Args a) {
    extern __shared__ __attribute__((aligned(16))) unsigned char lds[];
    cg::grid_group grid = cg::this_grid();
    const int G = gridDim.x, bx = blockIdx.x;
    const int vcu = (G % 8 == 0) ? (bx % 8) * (G / 8) + bx / 8 : bx;
    const int NGW = G * 8;
    LAS unsigned char* lds3 = (LAS unsigned char*)lds;
    int ph = 0;
    if (threadIdx.x < 16) ((LAS unsigned*)(lds3 + 131072 + 12288))[threadIdx.x] = 0u;
    __syncthreads();
    XcdBarrier bar = xcd_barrier_post((unsigned*)(a.ws + WS_CTL) + 1024, (volatile LAS unsigned*)(lds3 + 131072 + 12288));
    if (a.ph_hi == -12345) grid.sync();
#define RUN(k) (a.ph_lo <= (k) && (k) < a.ph_hi)
#define SEAM() do { if (a.ph_lo <= ph && ph + 1 < a.ph_hi) { for (int rp_ = 0; rp_ < NREP(1); ++rp_) xcd_barrier(bar); } ++ph; } while (0)
#define REP(k) _Pragma("unroll 1") for (int rp_ = 0; rp_ < NREP(k); ++rp_)

    if (RUN(ph)) { REP(2) p0_prologue(a, lds, vcu, NGW); }
    SEAM();
    if (RUN(ph)) mod_finalize(a, vcu, G);
    SEAM();
    for (int l = 0; l < 2; ++l) {
        unsigned char* wl = a.ws + WS_W + (size_t)l * WL;
        if (l == 0) { if (RUN(ph)) norm_phase(a, lds, vcu, NGW, true, false, 0, 0, true, 0, 0); SEAM(); }
        if (RUN(ph)) { pg8::Gemm g{(const bf16_t*)(a.ws + WS_H), (const bf16_t*)(wl + WO_GU1), D}; pg8::StaticOrder S; S.init(TOK, NGU, 1, G, bx, D);
            pg8::EpiSwiGLU E{(bf16_t*)(a.ws + WS_ACT)}; REP(5) pg8::gemm_phase(lds3, g, S, E); }
        SEAM();
        if (RUN(ph)) { pg8::Gemm g{(const bf16_t*)(a.ws + WS_ACT), (const bf16_t*)(wl + WO_D1), DFF}; pg8::StaticOrder S; S.init(TOK, D, 2, G, bx, DFF / 2);
            pg8::EpiBf16 E{(bf16_t*)(a.ws + WS_Y), D, (size_t)TOK * D}; REP(7) pg8::gemm_phase(lds3, g, S, E); }
        SEAM();
        if (RUN(ph)) { if (PROBE == 6) { for (int rp_ = 0; rp_ < 2; ++rp_) norm_phase(a, lds, vcu, NGW, false, true, l, 0, true, l, 1, true); } norm_phase(a, lds, vcu, NGW, l == 0, true, l, 0, true, l, 1); }
        SEAM();
        if (RUN(ph)) { pg8::Gemm g{(const bf16_t*)(a.ws + WS_H), (const bf16_t*)(wl + WO_MI), D}; pg8::MixInOrder S; S.init(G, bx);
            pg8::EpiMixIn E{(bf16_t*)(a.ws + WS_ACT), (bf16_t*)(a.ws + WS_Y)}; REP(8) pg8::gemm_phase(lds3, g, S, E); }
        SEAM();
        if (RUN(ph)) { REP(4) mix_prep(a, lds, l); }
        SEAM();
        if (RUN(ph)) { REP(3) attn_phase(a, lds, l, rp_); }
        SEAM();
        if (RUN(ph)) { pg8::Gemm g{(const bf16_t*)(a.ws + WS_CAT), (const bf16_t*)(wl + WO_MO), D}; pg8::StaticOrder S; S.init(TOK, D, 2, G, bx, D / 2);
            pg8::EpiBf16 E{(bf16_t*)(a.ws + WS_Y), D, (size_t)TOK * D}; REP(7) pg8::gemm_phase(lds3, g, S, E); }
        SEAM();
        if (RUN(ph)) norm_phase(a, lds, vcu, NGW, false, true, l, 1, true, l, 2);
        SEAM();
        if (RUN(ph)) { pg8::Gemm g{(const bf16_t*)(a.ws + WS_H), (const bf16_t*)(wl + WO_GU2), D}; pg8::StaticOrder S; S.init(TOK, NGU, 1, G, bx, D);
            pg8::EpiSwiGLU E{(bf16_t*)(a.ws + WS_ACT)}; REP(5) pg8::gemm_phase(lds3, g, S, E); }
        SEAM();
        if (RUN(ph)) { pg8::Gemm g{(const bf16_t*)(a.ws + WS_ACT), (const bf16_t*)(wl + WO_D2), DFF}; pg8::StaticOrder S; S.init(TOK, D, 2, G, bx, DFF / 2);
            pg8::EpiBf16 E{(bf16_t*)(a.ws + WS_Y), D, (size_t)TOK * D}; REP(7) pg8::gemm_phase(lds3, g, S, E); }
        SEAM();
        if (RUN(ph)) norm_phase(a, lds, vcu, NGW, false, true, l, 2, l == 0, 1, 0);
        SEAM();
    }
#undef RUN
#undef SEAM
}

extern "C" void kernel_launch(void* const* d_in, const int* in_sizes, int n_in, void* d_out, int out_size, void* d_ws, size_t ws_size, hipStream_t stream) {
    static int grid = 0;
    if (grid == 0) {
        if (n_in != 33 || ws_size < WS_END) { fprintf(stderr, "kernel_launch: unexpected n_in %d / ws_size %zu\n", n_in, ws_size); grid = -1; return; }
        int dev = 0, cus = 0, per_cu = 0;
        (void)hipGetDevice(&dev);
        (void)hipDeviceGetAttribute(&cus, hipDeviceAttributeMultiprocessorCount, dev);
        if (hipFuncSetAttribute((const void*)fwd_kernel, hipFuncAttributeMaxDynamicSharedMemorySize, LDS_BYTES) != hipSuccess) { fprintf(stderr, "kernel_launch: hipFuncSetAttribute failed\n"); grid = -1; return; }
        if (hipOccupancyMaxActiveBlocksPerMultiprocessor(&per_cu, (const void*)fwd_kernel, 512, LDS_BYTES) != hipSuccess || per_cu < 1) { fprintf(stderr, "kernel_launch: occupancy query gave %d\n", per_cu); per_cu = 1; }
        (void)hipGetLastError();
        grid = cus * 1;
    }
    if (grid < 0) return;
    (void)hipMemsetAsync((char*)d_ws + WS_CTL, 0, 65536, stream);
    Args a{};
    for (int i = 0; i < 33; ++i) a.in[i] = (const float*)d_in[i];
    a.out = (float*)d_out; a.ws = (unsigned char*)d_ws; a.ph_lo = 0; a.ph_hi = 1000;
    void* args[] = {&a};
    hipError_t e = hipLaunchCooperativeKernel((const void*)fwd_kernel, dim3(grid), dim3(512), args, LDS_BYTES, stream);
    if (e != hipSuccess) fprintf(stderr, "kernel_launch: cooperative launch failed: %s (grid %d)\n", hipGetErrorString(e), grid);
}
```

```cpp
#include <hip/hip_runtime.h>
#include <hip/hip_cooperative_groups.h>
#include <cstdio>
#include <cstdint>
namespace cg = cooperative_groups;
#ifndef PROBE
#define PROBE 0
#endif
#define NREP(k) ((PROBE == (k)) ? 3 : 1)

typedef unsigned short bf16_t;
typedef short bf16x8 __attribute__((ext_vector_type(8)));
typedef float f32x4 __attribute__((ext_vector_type(4)));
typedef float f32x16 __attribute__((ext_vector_type(16)));
typedef unsigned u32x4 __attribute__((ext_vector_type(4)));
typedef unsigned u32x2 __attribute__((ext_vector_type(2)));
#define LAS __attribute__((address_space(3)))

constexpr int D = 1024, TOK = 8192, CTX_TOK = 4096, DFF = 2816, NGU = 5632, MIXIN = 2560;
constexpr int SEQ_C = 256, SEQ_L = 2048, S_LAT = 2304, NMOD = 9216;
constexpr float EPS = 1e-6f;
constexpr float LOG2E = 1.4426950408889634f;

constexpr size_t MiB = 1u << 20;
constexpr size_t WS_CTL = 0;
constexpr size_t WS_MODP = 64 * 1024;
constexpr size_t WS_W = 2 * MiB, WL = 40 * MiB;
constexpr size_t WO_GU1 = 0, WO_D1 = 11 * MiB, WO_GU2 = 16 * MiB + 512 * 1024, WO_D2 = 27 * MiB + 512 * 1024, WO_MI = 33 * MiB, WO_MO = 38 * MiB;
constexpr size_t WS_H = 82 * MiB, WS_CAT = 98 * MiB, WS_ACT = 114 * MiB, WS_Y = 158 * MiB;
constexpr size_t WS_QD = 222 * MiB, WS_QG = 226 * MiB;
constexpr size_t WS_KDC = 230 * MiB, WS_VDC = 232 * MiB, WS_KGC = 234 * MiB, WS_VGC = 235 * MiB;
constexpr size_t WS_KDL = 236 * MiB, WS_VDL = 239 * MiB, WS_KGL = 242 * MiB, WS_VGL = 244 * MiB, WS_TAB = 246 * MiB, WS_END = 247 * MiB;

constexpr int LDS_BYTES = 131072 + 12288 + 64;

__device__ __forceinline__ float wave_sum(float v) {
#pragma unroll
    for (int o = 1; o < 64; o <<= 1) v += __shfl_xor(v, o);
    return v;
}
__device__ __forceinline__ unsigned f2bf(float f) { unsigned u = __builtin_bit_cast(unsigned, f); return (u + 0x7fffu + ((u >> 16) & 1u)) >> 16; }
typedef float f32x2_cv __attribute__((ext_vector_type(2))); typedef __bf16 bf16x2_cv __attribute__((ext_vector_type(2)));
__device__ __forceinline__ unsigned pk2(float lo, float hi) { f32x2_cv v = {lo, hi}; bf16x2_cv b = __builtin_convertvector(v, bf16x2_cv); return __builtin_bit_cast(unsigned, b); }
__device__ __forceinline__ float bf2f(bf16_t h) { return __builtin_bit_cast(float, (unsigned)h << 16); }
__device__ __forceinline__ float silu_f(float v) { return v * __builtin_amdgcn_rcpf(1.0f + __builtin_amdgcn_exp2f(-1.4426950408889634f * v)); }
__device__ __forceinline__ int tid_now() { int t = threadIdx.x; asm volatile("" : "+v"(t)); return t; }

namespace pg8 {
constexpr int BM = 256, BK = 64, HALF = 128, HTB = HALF * BK * 2, NXCD = 8, WGM = 8;
__host__ __device__ __forceinline__ int lds_byte(int r, int c) { const int st = (r >> 4) * 2 + (c >> 5), rr = r & 15, cc = c & 31, ob = rr * 64 + cc * 2; return st * 1024 + (ob ^ (((ob >> 9) & 1) << 5)); }
__host__ __device__ __forceinline__ void stage_rc(int b, int& R, int& C) { const int st = b / 1024, sb = b % 1024, swz = sb ^ (((sb >> 9) & 1) << 5); R = (st >> 1) * 16 + swz / 64; C = (st & 1) * 32 + (swz % 64) / 2; }
__host__ __device__ __forceinline__ int perm32(int rho) { const int n = rho >> 4, i = rho & 15; return 8 * (i >> 2) + 4 * n + (i & 3); }

struct Unit { int pm, pn, ks, nt, koff; };
struct Gemm { const bf16_t* A; const bf16_t* Bt; int ld; };

struct StaticOrder {
    int nM, nN, nNr, nwg, G, c, Kloop;
    __device__ void init(int M, int N, int KS, int G_, int c_, int Kloop_) { nM = M / BM; nNr = N / BM; nN = nNr * KS; nwg = nM * nN; G = G_; c = c_; Kloop = Kloop_; }
    __device__ bool next(int i, Unit& u) const {
        const long L = (long)i * G + c; if (L >= nwg) return false;
        int wgid = (int)L; { const int q = nwg / NXCD, r = nwg % NXCD, xcd = wgid % NXCD, off = wgid / NXCD; wgid = (xcd < r ? xcd * (q + 1) : r * (q + 1) + (xcd - r) * q) + off; }
        const int nig = WGM * nN, gid = wgid / nig, fm = gid * WGM, gsz = (nM - fm) < WGM ? (nM - fm) : WGM;
        u.pm = fm + ((wgid % nig) % gsz); const int pv = (wgid % nig) / gsz; u.pn = pv % nNr; u.ks = pv / nNr; u.nt = Kloop / BK; u.koff = u.ks * Kloop * 2; return true;
    }
};

struct MixInOrder {
    StaticOrder S8; int G, c;
    __device__ void init(int G_, int c_) { S8.init(TOK, 2048, 1, G_, c_, D); G = G_; c = c_; }
    __device__ bool next(int i, Unit& u) const {
        const long L = (long)i * G + c;
        if (L < 256) return S8.next(i, u);
        if (L >= 512) return false;
        const int idx = (int)L - 256, r = idx & 7; u.pm = idx >> 3; u.pn = 8 + (r & 1); u.ks = r >> 1; u.nt = 4; u.koff = u.ks * 512; return true;
    }
};

__device__ __forceinline__ unsigned cvt_pk_bf16(float lo, float hi) { f32x2_cv v = {lo, hi}; bf16x2_cv b = __builtin_convertvector(v, bf16x2_cv); return __builtin_bit_cast(unsigned, b); }

struct EpiBf16 {
    static constexpr bool PERM = true;
    bf16_t* O; int ldc; size_t ks_stride;
    __device__ __forceinline__ void operator()(const f32x4 (&acc)[2][2][4][2], const Unit& u, int wr, int wc, int fr, int fq) const {
        bf16_t* Ob = O + (size_t)u.ks * ks_stride;
        const int row0 = u.pm * BM + wr * 64 + fr; const int col0 = u.pn * BM + wc * 32 + 8 * fq;
#pragma unroll
        for (int ai = 0; ai < 2; ++ai)
#pragma unroll
            for (int m = 0; m < 4; ++m) { bf16_t* rowp = Ob + (size_t)(row0 + ai * HALF + m * 16) * ldc + col0;
#pragma unroll
                for (int bj = 0; bj < 2; ++bj) { const f32x4 v0 = acc[ai][bj][m][0], v1 = acc[ai][bj][m][1];
                    u32x4 w; w.x = cvt_pk_bf16(v0[0], v0[1]); w.y = cvt_pk_bf16(v0[2], v0[3]); w.z = cvt_pk_bf16(v1[0], v1[1]); w.w = cvt_pk_bf16(v1[2], v1[3]);
                    *(u32x4*)(rowp + bj * HALF) = w; } }
    }
};
struct EpiMixIn {
    static constexpr bool PERM = true;
    bf16_t* PROJ; bf16_t* PART;
    __device__ __forceinline__ void operator()(const f32x4 (&acc)[2][2][4][2], const Unit& u, int wr, int wc, int fr, int fq) const {
        const bool part = u.pn >= 8;
        bf16_t* Ob = part ? PART + (size_t)u.ks * TOK * 512 : PROJ; const int ldc = part ? 512 : MIXIN;
        const int row0 = u.pm * BM + wr * 64 + fr; const int col0 = (part ? u.pn - 8 : u.pn) * BM + wc * 32 + 8 * fq;
#pragma unroll
        for (int ai = 0; ai < 2; ++ai)
#pragma unroll
            for (int m = 0; m < 4; ++m) { bf16_t* rowp = Ob + (size_t)(row0 + ai * HALF + m * 16) * ldc + col0;
#pragma unroll
                for (int bj = 0; bj < 2; ++bj) { const f32x4 v0 = acc[ai][bj][m][0], v1 = acc[ai][bj][m][1];
                    u32x4 w; w.x = cvt_pk_bf16(v0[0], v0[1]); w.y = cvt_pk_bf16(v0[2], v0[3]); w.z = cvt_pk_bf16(v1[0], v1[1]); w.w = cvt_pk_bf16(v1[2], v1[3]);
                    *(u32x4*)(rowp + bj * HALF) = w; } }
    }
};
struct EpiSwiGLU {
    static constexpr bool PERM = true;
    bf16_t* O;
    __device__ __forceinline__ void operator()(const f32x4 (&acc)[2][2][4][2], const Unit& u, int wr, int wc, int fr, int fq) const {
        const int row0 = u.pm * BM + wr * 64 + fr; const int col0 = u.pn * HALF + wc * 32 + 8 * fq;
#pragma unroll
        for (int ai = 0; ai < 2; ++ai)
#pragma unroll
            for (int m = 0; m < 4; ++m) { bf16_t* rowp = O + (size_t)(row0 + ai * HALF + m * 16) * DFF + col0;
                const f32x4 g0 = acc[ai][0][m][0], g1 = acc[ai][0][m][1], u0 = acc[ai][1][m][0], u1 = acc[ai][1][m][1];
                float r[8];
#pragma unroll
                for (int i = 0; i < 4; ++i) { r[i] = silu_f(g0[i]) * u0[i]; r[4 + i] = silu_f(g1[i]) * u1[i]; }
                u32x4 w; w.x = cvt_pk_bf16(r[0], r[1]); w.y = cvt_pk_bf16(r[2], r[3]); w.z = cvt_pk_bf16(r[4], r[5]); w.w = cvt_pk_bf16(r[6], r[7]);
                *(u32x4*)rowp = w; }
    }
};
struct EpiF32 {
    static constexpr bool PERM = false;
    float* O; int ldc; size_t ks_stride;
    __device__ __forceinline__ void operator()(const f32x4 (&acc)[2][2][4][2], const Unit& u, int wr, int wc, int fr, int fq) const {
        float* base = O + (size_t)u.ks * ks_stride;
        const int row0 = u.pm * BM + wr * 64 + fr; const int col0 = u.pn * BM + wc * 32 + 4 * fq;
#pragma unroll
        for (int ai = 0; ai < 2; ++ai)
#pragma unroll
            for (int m = 0; m < 4; ++m) { float* rowp = base + (size_t)(row0 + ai * HALF + m * 16) * ldc + col0;
#pragma unroll
                for (int bj = 0; bj < 2; ++bj)
#pragma unroll
                    for (int n = 0; n < 2; ++n) *(f32x4*)(rowp + bj * HALF + n * 16) = acc[ai][bj][m][n]; }
    }
};

template <class Epi, class Sched>
__device__ __forceinline__ void gemm_phase(LAS unsigned char* lds, const Gemm g, const Sched& S, const Epi& E) {
    const int tid = tid_now(), wid = __builtin_amdgcn_readfirstlane(tid >> 6), lane = tid & 63, wr = wid >> 2, wc = wid & 3, fr = lane & 15, fq = lane >> 4;
    const int K = g.ld;
    unsigned voffA[2], voffB[2];
#pragma unroll
    for (int i = 0; i < 2; ++i) { int R, C; stage_rc(tid * 16 + i * 8192, R, C); const int Rb = Epi::PERM ? ((R & ~31) + perm32(R & 31)) : R;
        voffA[i] = (unsigned)(R * K + C) * 2u; voffB[i] = (unsigned)(Rb * K + C) * 2u; }
    const size_t kstep = (size_t)(BK * 2);
    const size_t hstep = (size_t)HALF * K * 2;
    const size_t tstep = 2 * hstep;
    const unsigned ldsw = (unsigned)wid * 1024u;
    const int aoff = lds_byte(wr * 64 + fr, fq * 8), boff = lds_byte(wc * 32 + fr, fq * 8);
#define PG8_SA(b, h) (((b) * 2 + (h)) * HTB)
#define PG8_SB(b, h) ((4 + (b) * 2 + (h)) * HTB)
#define PG8_STAGE(bufoff, gbase, voff) do { _Pragma("unroll") for (int _i = 0; _i < 2; ++_i) \
        __builtin_amdgcn_global_load_lds((const unsigned*)((const char*)(gbase) + (voff)[_i]), (LAS unsigned*)(lds + (bufoff) + ldsw + _i * 8192), 16, 0, 0); } while (0)
#define PG8_LDA(dst, b, h) do { _Pragma("unroll") for (int m = 0; m < 4; ++m) _Pragma("unroll") for (int k = 0; k < 2; ++k) dst[m][k] = *(const LAS bf16x8*)(lds + PG8_SA(b, h) + aoff + m * 2048 + k * 1024); } while (0)
#define PG8_LDB(dst, b, h) do { _Pragma("unroll") for (int n = 0; n < 2; ++n) _Pragma("unroll") for (int k = 0; k < 2; ++k) dst[n][k] = *(const LAS bf16x8*)(lds + PG8_SB(b, h) + boff + n * 2048 + k * 1024); } while (0)
#define PG8_MMA(ai, bj, At, Bt) do { __builtin_amdgcn_s_setprio(1); _Pragma("unroll") for (int m = 0; m < 4; ++m) _Pragma("unroll") for (int n = 0; n < 2; ++n) _Pragma("unroll") for (int k = 0; k < 2; ++k) \
        acc[ai][bj][m][n] = __builtin_amdgcn_mfma_f32_16x16x32_bf16(Bt[n][k], At[m][k], acc[ai][bj][m][n], 0, 0, 0); __builtin_amdgcn_s_setprio(0); } while (0)
#define PG8_WAIT_V(n) asm volatile("s_waitcnt vmcnt(" #n ")" ::: "memory")
#define PG8_WAIT_L(n) asm volatile("s_waitcnt lgkmcnt(" #n ")" ::: "memory")
#define PG8_BAR __builtin_amdgcn_s_barrier()
#define PG8_SCHED __builtin_amdgcn_sched_barrier(0)
    Unit cur, nxt; int ui = 0;
    if (!S.next(0, cur)) return;
    f32x4 acc[2][2][4][2];
#pragma unroll
    for (int a = 0; a < 2; ++a)
#pragma unroll
        for (int b = 0; b < 2; ++b)
#pragma unroll
            for (int m = 0; m < 4; ++m)
#pragma unroll
                for (int n = 0; n < 2; ++n) acc[a][b][m][n] = (f32x4){0.f, 0.f, 0.f, 0.f};
    bf16x8 At[4][2], B0[2][2], B1[2][2];
    const char* cA = (const char*)g.A + (size_t)cur.pm * tstep + (size_t)cur.koff; const char* cB = (const char*)g.Bt + (size_t)cur.pn * tstep + (size_t)cur.koff;
    PG8_STAGE(PG8_SB(0, 0), cB, voffB); PG8_STAGE(PG8_SB(0, 1), cB + hstep, voffB); PG8_STAGE(PG8_SA(0, 0), cA, voffA); PG8_STAGE(PG8_SA(0, 1), cA + hstep, voffA);
    if (wr == 1) PG8_BAR;
    PG8_WAIT_V(2); PG8_BAR;
    PG8_STAGE(PG8_SB(1, 0), cB + kstep, voffB); PG8_STAGE(PG8_SA(1, 0), cA + kstep, voffA); PG8_STAGE(PG8_SB(1, 1), cB + hstep + kstep, voffB);
    PG8_WAIT_V(6); PG8_BAR;
    for (;;) {
        const bool has_next = S.next(ui + 1, nxt);
        const char* nA = has_next ? (const char*)g.A + (size_t)nxt.pm * tstep + (size_t)nxt.koff : cA; const char* nB = has_next ? (const char*)g.Bt + (size_t)nxt.pn * tstep + (size_t)nxt.koff : cB;
        const int nt = cur.nt;
        for (int t = 0; t < nt; t += 2) {
            const bool last = (t == nt - 2);
            const char* a1 = cA + (size_t)(t + 1) * kstep;
            const char* a2 = last ? nA : cA + (size_t)(t + 2) * kstep; const char* b2 = last ? nB : cB + (size_t)(t + 2) * kstep;
            const char* a3 = a2 + kstep; const char* b3 = b2 + kstep;
            PG8_LDB(B0, 0, 0); PG8_LDB(B1, 0, 1); PG8_SCHED; PG8_LDA(At, 0, 0); PG8_STAGE(PG8_SA(1, 1), a1 + hstep, voffA);
            PG8_WAIT_V(8); PG8_WAIT_L(0); PG8_BAR; PG8_MMA(0, 0, At, B0); PG8_MMA(0, 1, At, B1); PG8_BAR; PG8_SCHED;
            PG8_LDA(At, 0, 1); PG8_STAGE(PG8_SB(0, 0), b2, voffB); PG8_STAGE(PG8_SB(0, 1), b2 + hstep, voffB); PG8_STAGE(PG8_SA(0, 0), a2, voffA);
            PG8_WAIT_V(8); PG8_WAIT_L(0); PG8_BAR; PG8_MMA(1, 0, At, B0); PG8_MMA(1, 1, At, B1); PG8_BAR; PG8_SCHED;
            PG8_LDB(B0, 1, 0); PG8_LDB(B1, 1, 1); PG8_SCHED; PG8_LDA(At, 1, 0); PG8_STAGE(PG8_SA(0, 1), a2 + hstep, voffA);
            PG8_WAIT_V(8); PG8_WAIT_L(0); PG8_BAR; PG8_MMA(0, 0, At, B0); PG8_MMA(0, 1, At, B1); PG8_BAR; PG8_SCHED;
            PG8_LDA(At, 1, 1); PG8_STAGE(PG8_SB(1, 0), b3, voffB); PG8_STAGE(PG8_SB(1, 1), b3 + hstep, voffB); PG8_STAGE(PG8_SA(1, 0), a3, voffA);
            PG8_WAIT_V(8); PG8_WAIT_L(0); PG8_BAR; PG8_MMA(1, 0, At, B0); PG8_MMA(1, 1, At, B1); PG8_BAR; PG8_SCHED;
        }
        if (wr == 0) PG8_BAR;
        E(acc, cur, wr, wc, fr, fq);
        if (!has_next) break;
#pragma unroll
        for (int a = 0; a < 2; ++a)
#pragma unroll
            for (int b = 0; b < 2; ++b)
#pragma unroll
                for (int m = 0; m < 4; ++m)
#pragma unroll
                    for (int n = 0; n < 2; ++n) acc[a][b][m][n] = (f32x4){0.f, 0.f, 0.f, 0.f};
        cur = nxt; cA = nA; cB = nB; ++ui;
        if (wr == 1) PG8_BAR;
    }
    PG8_WAIT_V(0);
    PG8_BAR;
#undef PG8_SA
#undef PG8_SB
#undef PG8_STAGE
#undef PG8_LDA
#undef PG8_LDB
#undef PG8_MMA
#undef PG8_WAIT_V
#undef PG8_WAIT_L
#undef PG8_BAR
#undef PG8_SCHED
}
}

struct Args { const float* in[33]; float* out; unsigned char* ws; int ph_lo, ph_hi; };
enum { I_XP = 0, I_XS, I_CDK, I_CDV, I_CGK, I_CGV, I_C, I_CCTX, I_WADA, I_BADA, I_NPRE, I_NPOST, I_F1G, I_F1U, I_F1D, I_F2G, I_F2U, I_F2D,
       I_WMI, I_WMO, I_SCW, I_LQ1, I_LK1, I_LQ2, I_LK2, I_SUBLN, I_CDWW, I_CDWB, I_CLNG, I_CLNB, I_CPW, I_QNORM, I_KNORM };

__device__ __forceinline__ const float* inptr(int i) {
    typedef const char __attribute__((address_space(4)))* kptr_t;
    kptr_t kp = (kptr_t)__builtin_amdgcn_kernarg_segment_ptr();
    unsigned off = 8u * (unsigned)i; asm volatile("" : "+s"(off));
    return *(const float* const __attribute__((address_space(4)))*)(kp + off);
}
__device__ __forceinline__ void tr_item(const float* W, int ldw, bf16_t* WT, int ldt, int k0, int n0, int orow0, float* scr, int lane) {
    f32x4 v[8];
    const int lr = lane >> 3, lc = (lane & 7) * 4;
#pragma unroll
    for (int i = 0; i < 8; ++i) v[i] = *(const f32x4*)(W + (size_t)(k0 + 8 * i + lr) * ldw + n0 + lc);
#pragma unroll
    for (int i = 0; i < 8; ++i) { float* d = scr + (8 * i + lr) * 33 + lc; d[0] = v[i][0]; d[1] = v[i][1]; d[2] = v[i][2]; d[3] = v[i][3]; }
    asm volatile("s_waitcnt lgkmcnt(0)" ::: "memory");
    const int c = lane & 7;
#pragma unroll
    for (int j = 0; j < 4; ++j) { const int n = (lane >> 3) + 8 * j; const float* s = scr + (8 * c) * 33 + n;
        u32x4 o; o.x = pk2(s[0 * 33], s[1 * 33]); o.y = pk2(s[2 * 33], s[3 * 33]); o.z = pk2(s[4 * 33], s[5 * 33]); o.w = pk2(s[6 * 33], s[7 * 33]);
        *(u32x4*)(WT + (size_t)(orow0 + n) * ldt + k0 + 8 * c) = o; }
    asm volatile("s_waitcnt lgkmcnt(0)" ::: "memory");
}

__device__ __forceinline__ void p0_prologue(const Args& a, unsigned char* lds, int vcu, int NGW) {
    const int tid = tid_now(), lane = tid & 63, wave = __builtin_amdgcn_readfirstlane(tid >> 6), gw = vcu * 8 + wave;
    float* SC = (float*)(lds + 131072);
    for (int i = tid; i < 3 * 1024; i += 512) { const int c = i >> 10, k = i & 1023; const float v = (c == 0) ? inptr(I_CCTX)[k] : inptr(I_C)[(c - 1) * 1024 + k]; SC[i] = silu_f(v); }
    __syncthreads();
    float* scr = (float*)(lds + wave * 16384);
    float* MODP = (float*)(a.ws + WS_MODP);
    constexpr int N_ADA = 2304, N_FOLD = 1024, N_TRL = 10112, N_TR = 2 * N_TRL, NIT = N_ADA + N_FOLD + N_TR;
    for (int it = gw; it < NIT; it += NGW) {
        if (it < N_ADA) {
            const int l = it / 1152, r2 = it % 1152, cb = r2 >> 3, kc = r2 & 7, col = cb * 64 + lane;
            const float* W = inptr(I_WADA) + (size_t)l * 1024 * NMOD + (size_t)(kc * 128) * NMOD + col;
            const float* s0 = SC + kc * 128;
            float a0 = 0.f, a1 = 0.f, a2 = 0.f;
#pragma unroll 32
            for (int k = 0; k < 128; ++k) { const float w = W[(size_t)k * NMOD]; a0 += s0[k] * w; a1 += s0[1024 + k] * w; a2 += s0[2048 + k] * w; }
            float* o = MODP + (size_t)((l * 8 + kc) * 3) * NMOD + col;
            o[0] = a0; o[NMOD] = a1; o[2 * NMOD] = a2;
        } else if (it < N_ADA + N_FOLD) {
            const int r = it - N_ADA, l = r >> 9, r2 = r & 511, kg = r2 >> 4, nb = r2 & 15, k0 = kg * 8, n = nb * 64 + lane;
            const float* pw = inptr(I_CPW) + (size_t)l * 65536 + (size_t)k0 * 256;
            const float* wm = inptr(I_WMO) + (size_t)l * 1048576 + (size_t)512 * 1024 + n;
            float acc[8];
#pragma unroll
            for (int q = 0; q < 8; ++q) acc[q] = 0.f;
#pragma unroll 16
            for (int j = 0; j < 256; ++j) { const float wv = wm[(size_t)j * 1024];
#pragma unroll
                for (int q = 0; q < 8; ++q) acc[q] += pw[q * 256 + j] * wv; }
            bf16_t* WT = (bf16_t*)(a.ws + WS_W + l * WL + WO_MO);
            u32x4 o; o.x = pk2(acc[0], acc[1]); o.y = pk2(acc[2], acc[3]); o.z = pk2(acc[4], acc[5]); o.w = pk2(acc[6], acc[7]);
            *(u32x4*)(WT + (size_t)n * 1024 + 512 + k0) = o;
        } else {
            int r = it - N_ADA - N_FOLD; const int l = r / N_TRL; r %= N_TRL;
            unsigned char* wl = a.ws + WS_W + l * WL;
            if (r < 8448) {
                const int which = r / 1408, q = r % 1408;
                const int ffn = which / 3, kind = which % 3;
                const float* W = inptr((ffn ? I_F2G : I_F1G) + kind) + (size_t)l * 1024 * DFF;
                if (kind < 2) { const int kb = q / 88, nb = q % 88, n0 = nb * 32;
                    tr_item(W, DFF, (bf16_t*)(wl + (ffn ? WO_GU2 : WO_GU1)), 1024, kb * 64, n0, (n0 >> 7) * 256 + (n0 & 127) + kind * 128, scr, lane); }
                else { const int kb = q / 32, nb = q % 32;
                    tr_item(W, 1024, (bf16_t*)(wl + (ffn ? WO_D2 : WO_D1)), DFF, kb * 64, nb * 32, nb * 32, scr, lane); }
            } else if (r < 8448 + 1280) { const int q = r - 8448, kb = q / 80, nb = q % 80;
                tr_item(inptr(I_WMI) + (size_t)l * 1024 * MIXIN, MIXIN, (bf16_t*)(wl + WO_MI), 1024, kb * 64, nb * 32, nb * 32, scr, lane);
            } else { const int q = r - 9728, kbi = q / 32, nb = q % 32, kb = kbi < 8 ? kbi : kbi + 4;
                tr_item(inptr(I_WMO) + (size_t)l * 1048576, 1024, (bf16_t*)(wl + WO_MO), 1024, kb * 64, nb * 32, nb * 32, scr, lane);
            }
        }
    }
}

__device__ __forceinline__ void mod_finalize(const Args& a, int vcu, int G) {
    const int tid = tid_now();
    const float* MODP = (const float*)(a.ws + WS_MODP); float* TAB = (float*)(a.ws + WS_TAB);
    const float* bada = inptr(I_BADA); const float* npost = inptr(I_NPOST); const float* npre = inptr(I_NPRE);
    for (int idx = vcu * 512 + tid; idx < 2 * 27 * 1024; idx += G * 512) {
        const int j = idx & 1023; int t = idx >> 10; const int c = t % 3; t /= 3; const int kind = t % 3; t /= 3; const int i = t % 3, l = t / 3;
        const int mi = kind == 0 ? 3 * i + 2 : (kind == 1 ? 3 * i + 1 : 3 * i);
        float v = bada[(size_t)l * NMOD + mi * 1024 + j];
#pragma unroll
        for (int kc = 0; kc < 8; ++kc) v += MODP[(size_t)((l * 8 + kc) * 3 + c) * NMOD + mi * 1024 + j];
        const float gs = (i == 1) ? 1.0f : 0.5f;
        TAB[idx] = kind == 0 ? gs * v * npost[(l * 3 + i) * 1024 + j] : (kind == 1 ? (1.0f + v) * npre[(l * 3 + i) * 1024 + j] : v);
    }
}

__device__ __forceinline__ void norm_phase(const Args& a, unsigned char* lds, int vcu, int NGW,
                                           bool first, bool has_prev, int lp, int ip, bool has_next, int ln, int in_, bool dry = false) {
    const int tid = tid_now(), lane = tid & 63, wave = __builtin_amdgcn_readfirstlane(tid >> 6), gw = vcu * 8 + wave;
    float* MV = (float*)lds;
    const float* TAB = (const float*)(a.ws + WS_TAB);
    __syncthreads();
    for (int idx = tid * 4; idx < 9216; idx += 2048) {
        const int kind = idx / 3072, rem = idx % 3072;
        const int l = kind == 0 ? lp : ln, i = kind == 0 ? ip : in_;
        f32x4 v = (f32x4){0.f, 0.f, 0.f, 0.f};
        if (kind == 0 ? has_prev : has_next) v = *(const f32x4*)(TAB + (size_t)(((l * 3 + i) * 3 + kind) * 3) * 1024 + rem);
        *(f32x4*)(MV + idx) = v;
    }
    __syncthreads();
    float* X = a.out; float* XO = dry ? (float*)(a.ws + WS_ACT) : a.out;
    const bf16_t* Y0 = (const bf16_t*)(a.ws + WS_Y); const bf16_t* Y1 = Y0 + (size_t)TOK * D;
    bf16_t* H = (bf16_t*)(a.ws + (dry ? WS_CAT : WS_H));
    const float* xp = inptr(I_XP); const float* xsm = inptr(I_XS);
    constexpr int R = 4;
    const int co = 8 * lane;
    for (int r0 = gw; r0 < TOK; r0 += R * NGW) {
        f32x4 x[R][4]; u32x4 ya[R][2], yb[R][2];
#pragma unroll
        for (int rr = 0; rr < R; ++rr) { const int row = r0 + rr * NGW;
            if (row < TOK) {
                const float* xs = first ? (row < CTX_TOK ? xp + (size_t)row * D : xsm + (size_t)(row - CTX_TOK) * D) : X + (size_t)row * D;
#pragma unroll
                for (int j = 0; j < 2; ++j) { x[rr][2 * j] = *(const f32x4*)(xs + co + 512 * j); x[rr][2 * j + 1] = *(const f32x4*)(xs + co + 512 * j + 4); }
                if (has_prev) {
#pragma unroll
                    for (int j = 0; j < 2; ++j) { ya[rr][j] = *(const u32x4*)(Y0 + (size_t)row * D + co + 512 * j); yb[rr][j] = *(const u32x4*)(Y1 + (size_t)row * D + co + 512 * j); }
                }
            } }
#pragma unroll
        for (int rr = 0; rr < R; ++rr) { const int row = r0 + rr * NGW;
            if (row < TOK) {
                const int c = row < CTX_TOK ? 0 : (row < CTX_TOK + SEQ_L ? 1 : 2);
                if (has_prev) {
                    f32x4 y[4]; float s = 0.f;
#pragma unroll
                    for (int j = 0; j < 2; ++j) {
#pragma unroll
                        for (int q = 0; q < 4; ++q) { const unsigned wa = ya[rr][j][q], wb = yb[rr][j][q];
                            const float lo = __builtin_bit_cast(float, wa << 16) + __builtin_bit_cast(float, wb << 16);
                            const float hi = __builtin_bit_cast(float, wa & 0xffff0000u) + __builtin_bit_cast(float, wb & 0xffff0000u);
                            y[2 * j + (q >> 1)][2 * (q & 1)] = lo; y[2 * j + (q >> 1)][2 * (q & 1) + 1] = hi; s += lo * lo + hi * hi; } }
                    const float ry = rsqrtf(wave_sum(s) * (1.0f / D) + EPS);
#pragma unroll
                    for (int j = 0; j < 2; ++j)
#pragma unroll
                        for (int h2 = 0; h2 < 2; ++h2) { const f32x4 gp = *(const f32x4*)(MV + c * 1024 + co + 512 * j + 4 * h2); x[rr][2 * j + h2] = x[rr][2 * j + h2] + gp * y[2 * j + h2] * ry; }
                }
                if (has_prev) {
#pragma unroll
                    for (int j = 0; j < 2; ++j) { *(f32x4*)(XO + (size_t)row * D + co + 512 * j) = x[rr][2 * j]; *(f32x4*)(XO + (size_t)row * D + co + 512 * j + 4) = x[rr][2 * j + 1]; }
                }
                if (has_next) {
                    float s = 0.f;
#pragma unroll
                    for (int q = 0; q < 4; ++q) s += (x[rr][q][0] * x[rr][q][0] + x[rr][q][1] * x[rr][q][1]) + (x[rr][q][2] * x[rr][q][2] + x[rr][q][3] * x[rr][q][3]);
                    const float rx = rsqrtf(wave_sum(s) * (1.0f / D) + EPS);
#pragma unroll
                    for (int j = 0; j < 2; ++j) {
                        const f32x4 a0 = *(const f32x4*)(MV + 3072 + c * 1024 + co + 512 * j), a1 = *(const f32x4*)(MV + 3072 + c * 1024 + co + 512 * j + 4);
                        const f32x4 s0 = *(const f32x4*)(MV + 6144 + c * 1024 + co + 512 * j), s1 = *(const f32x4*)(MV + 6144 + c * 1024 + co + 512 * j + 4);
                        const f32x4 h0 = x[rr][2 * j] * rx * a0 + s0, h1 = x[rr][2 * j + 1] * rx * a1 + s1;
                        u32x4 w; w.x = pg8::cvt_pk_bf16(h0[0], h0[1]); w.y = pg8::cvt_pk_bf16(h0[2], h0[3]); w.z = pg8::cvt_pk_bf16(h1[0], h1[1]); w.w = pg8::cvt_pk_bf16(h1[2], h1[3]);
                        *(u32x4*)(H + (size_t)row * D + co + 512 * j) = w; }
                }
            } }
    }
}

__device__ __forceinline__ void rope_pair(float& x, float xp, float ang, bool second) {
    const float s = __sinf(ang), c = __cosf(ang);
    x = second ? (xp * s + x * c) : (x * c - xp * s);
}
__device__ __forceinline__ float bflo(unsigned w) { return __builtin_bit_cast(float, w << 16); }
__device__ __forceinline__ float bfhi(unsigned w) { return __builtin_bit_cast(float, w & 0xffff0000u); }
__device__ __forceinline__ void mix_prep(const Args& a, unsigned char* lds, int l) {
    const int tid = tid_now(), lane = tid & 63, wave = __builtin_amdgcn_readfirstlane(tid >> 6);
    const bf16_t* PROJ = (const bf16_t*)(a.ws + WS_ACT);
    bf16_t* CAT = (bf16_t*)(a.ws + WS_CAT);
    bf16_t* QD = (bf16_t*)(a.ws + WS_QD); bf16_t* QG = (bf16_t*)(a.ws + WS_QG);
    float* U = (float*)lds;
    float* VB = (float*)(lds + 65536);
    const float qs_d = 0.17677669529663687f * LOG2E, qs_g = 0.125f * LOG2E;
    const float L2T = 13.287712379549449f;
    float invd[4], invg[4], invk[2];
#pragma unroll
    for (int t = 0; t < 4; ++t) { invd[t] = exp2f(-(float)(4 * (lane & 1) + t) * (L2T / 8.0f)); invg[t] = exp2f(-(float)(4 * (lane & 3) + t) * (L2T / 16.0f)); }
#pragma unroll
    for (int t = 0; t < 2; ++t) invk[t] = exp2f(-(float)(2 * (lane & 7) + t) * (L2T / 16.0f));
    for (int tile = blockIdx.x; tile < TOK / 32; tile += gridDim.x) {
        const int row0 = tile * 32; const bool lat = row0 >= CTX_TOK;
        int seq, pos0, seqlen;
        if (!lat) { seq = row0 / SEQ_C; pos0 = row0 % SEQ_C; seqlen = SEQ_C; } else { seq = (row0 - CTX_TOK) / SEQ_L; pos0 = (row0 - CTX_TOK) % SEQ_L; seqlen = SEQ_L; }
        bf16_t* KD = lat ? (bf16_t*)(a.ws + WS_KDL) + (size_t)(seq * S_LAT + 256) * 256 : (bf16_t*)(a.ws + WS_KDC) + (size_t)(seq * SEQ_C) * 256;
        bf16_t* VD = lat ? (bf16_t*)(a.ws + WS_VDL) + (size_t)(seq * S_LAT + 256) * 256 : (bf16_t*)(a.ws + WS_VDC) + (size_t)(seq * SEQ_C) * 256;
        bf16_t* KG = lat ? (bf16_t*)(a.ws + WS_KGL) + (size_t)(seq * S_LAT + 256) * 128 : (bf16_t*)(a.ws + WS_KGC) + (size_t)(seq * SEQ_C) * 128;
        bf16_t* VG = lat ? (bf16_t*)(a.ws + WS_VGL) + (size_t)(seq * S_LAT + 256) * 128 : (bf16_t*)(a.ws + WS_VGC) + (size_t)(seq * SEQ_C) * 128;
#pragma unroll 1
        for (int hh = 0; hh < 2; ++hh) {
            const int row_b = row0 + wave * 4 + hh * 2, pos_b = pos0 + wave * 4 + hh * 2;
            u32x2 dq[2], dk[2], dv[2], gqp[2][4], ab[2], ac[4], ah[4]; unsigned gkp[2][4], gvp[2][4];
#pragma unroll
            for (int rr = 0; rr < 2; ++rr) { const bf16_t* pr = PROJ + (size_t)(row_b + rr) * MIXIN;
                dq[rr] = *(const u32x2*)(pr + 768 + 4 * lane); dk[rr] = *(const u32x2*)(pr + 1024 + 4 * lane); dv[rr] = *(const u32x2*)(pr + 1280 + 4 * lane);
                ab[rr] = *(const u32x2*)(pr + 4 * lane); }
#pragma unroll
            for (int t = 0; t < 4; ++t) { const int tp = pos_b - 1 + t; const bool valid = tp >= 0 && tp < seqlen; const bf16_t* pr = PROJ + (size_t)(row_b - 1 + t) * MIXIN;
                ac[t] = (u32x2){0u, 0u}; ah[t] = (u32x2){0u, 0u};
                if (valid) { ac[t] = *(const u32x2*)(pr + 256 + 4 * lane); ah[t] = *(const u32x2*)(pr + 512 + 4 * lane); } }
#pragma unroll
            for (int rr = 0; rr < 2; ++rr) { const int row = row_b + rr, pos = pos_b + rr;
                float q[4] = {bflo(dq[rr].x), bfhi(dq[rr].x), bflo(dq[rr].y), bfhi(dq[rr].y)};
                float k[4] = {bflo(dk[rr].x), bfhi(dk[rr].x), bflo(dk[rr].y), bfhi(dk[rr].y)};
                if (lat) {
                    const float pax = (float)((lane & 4) ? (pos & 63) : (pos >> 6)); const bool second = (lane & 2) != 0;
#pragma unroll
                    for (int t = 0; t < 4; ++t) { const float ang = pax * invd[t]; const float sn = __sinf(ang), cs = __cosf(ang);
                        const float qp = __shfl_xor(q[t], 2), kp = __shfl_xor(k[t], 2);
                        q[t] = second ? (qp * sn + q[t] * cs) : (q[t] * cs - qp * sn); k[t] = second ? (kp * sn + k[t] * cs) : (k[t] * cs - kp * sn); }
                } else {
                    float* odk = a.out + 8388608 + ((size_t)(seq * 2 + l) * 256 + pos) * 256 + 4 * lane;
                    float* odv = a.out + 10485760 + ((size_t)(seq * 2 + l) * 256 + pos) * 256 + 4 * lane;
                    *(f32x4*)odk = (f32x4){k[0], k[1], k[2], k[3]};
                    *(f32x4*)odv = (f32x4){bflo(dv[rr].x), bfhi(dv[rr].x), bflo(dv[rr].y), bfhi(dv[rr].y)};
                }
                u32x2 w; w.x = pg8::cvt_pk_bf16(q[0] * qs_d, q[1] * qs_d); w.y = pg8::cvt_pk_bf16(q[2] * qs_d, q[3] * qs_d);
                *(u32x2*)(QD + (size_t)row * 256 + 4 * lane) = w;
                w.x = pg8::cvt_pk_bf16(k[0], k[1]); w.y = pg8::cvt_pk_bf16(k[2], k[3]);
                *(u32x2*)(KD + (size_t)pos * 256 + 4 * lane) = w;
                *(u32x2*)(VD + (size_t)pos * 256 + 4 * lane) = dv[rr];
            }
            asm volatile("" ::: "memory");
            const bf16_t* PART = (const bf16_t*)(a.ws + WS_Y);
#pragma unroll
            for (int rr = 0; rr < 2; ++rr)
#pragma unroll
                for (int ks = 0; ks < 4; ++ks) { const bf16_t* pp = PART + ((size_t)ks * TOK + row_b + rr) * 512;
                    gqp[rr][ks] = *(const u32x2*)(pp + 4 * lane); gkp[rr][ks] = *(const unsigned*)(pp + 256 + 2 * lane); gvp[rr][ks] = *(const unsigned*)(pp + 384 + 2 * lane); }
            const f32x4 qnv = *(const f32x4*)(inptr(I_QNORM) + l * 64 + 4 * (lane & 15));
#pragma unroll
            for (int rr = 0; rr < 2; ++rr) { const int row = row_b + rr, pos = pos_b + rr;
                float q[4] = {0.f, 0.f, 0.f, 0.f};
#pragma unroll
                for (int ks = 0; ks < 4; ++ks) { q[0] += bflo(gqp[rr][ks].x); q[1] += bfhi(gqp[rr][ks].x); q[2] += bflo(gqp[rr][ks].y); q[3] += bfhi(gqp[rr][ks].y); }
                float ss = (q[0] * q[0] + q[1] * q[1]) + (q[2] * q[2] + q[3] * q[3]);
                ss += __shfl_xor(ss, 1); ss += __shfl_xor(ss, 2); ss += __shfl_xor(ss, 4); ss += __shfl_xor(ss, 8);
                const float rn = rsqrtf(ss * (1.0f / 64.0f) + EPS);
#pragma unroll
                for (int t = 0; t < 4; ++t) q[t] = q[t] * rn * qnv[t];
                if (lat) {
                    const float pax = (float)((lane & 8) ? (pos & 63) : (pos >> 6)); const bool second = (lane & 4) != 0;
#pragma unroll
                    for (int t = 0; t < 4; ++t) { const float ang = pax * invg[t]; const float sn = __sinf(ang), cs = __cosf(ang);
                        const float qp = __shfl_xor(q[t], 4);
                        q[t] = second ? (qp * sn + q[t] * cs) : (q[t] * cs - qp * sn); }
                }
                u32x2 w; w.x = pg8::cvt_pk_bf16(q[0] * qs_g, q[1] * qs_g); w.y = pg8::cvt_pk_bf16(q[2] * qs_g, q[3] * qs_g);
                *(u32x2*)(QG + (size_t)row * 256 + 4 * lane) = w;
            }
            const float kn0 = inptr(I_KNORM)[l * 64 + 2 * (lane & 31)], kn1 = inptr(I_KNORM)[l * 64 + 2 * (lane & 31) + 1];
#pragma unroll
            for (int rr = 0; rr < 2; ++rr) { const int pos = pos_b + rr;
                float k0 = 0.f, k1 = 0.f, v0 = 0.f, v1 = 0.f;
#pragma unroll
                for (int ks = 0; ks < 4; ++ks) { k0 += bflo(gkp[rr][ks]); k1 += bfhi(gkp[rr][ks]); v0 += bflo(gvp[rr][ks]); v1 += bfhi(gvp[rr][ks]); }
                const unsigned vpk = pg8::cvt_pk_bf16(v0, v1);
                float ss = k0 * k0 + k1 * k1;
                ss += __shfl_xor(ss, 1); ss += __shfl_xor(ss, 2); ss += __shfl_xor(ss, 4); ss += __shfl_xor(ss, 8); ss += __shfl_xor(ss, 16);
                const float rn = rsqrtf(ss * (1.0f / 64.0f) + EPS);
                k0 = k0 * rn * kn0; k1 = k1 * rn * kn1;
                if (lat) {
                    const float pax = (float)((lane & 16) ? (pos & 63) : (pos >> 6)); const bool second = (lane & 8) != 0;
                    const float a0 = pax * invk[0], a1 = pax * invk[1];
                    const float s0 = __sinf(a0), c0 = __cosf(a0), s1 = __sinf(a1), c1 = __cosf(a1);
                    const float p0 = __shfl_xor(k0, 8), p1 = __shfl_xor(k1, 8);
                    k0 = second ? (p0 * s0 + k0 * c0) : (k0 * c0 - p0 * s0); k1 = second ? (p1 * s1 + k1 * c1) : (k1 * c1 - p1 * s1);
                } else {
                    float* ogk = a.out + 12582912 + ((size_t)(seq * 2 + l) * 256 + pos) * 128 + 2 * lane;
                    float* ogv = a.out + 13631488 + ((size_t)(seq * 2 + l) * 256 + pos) * 128 + 2 * lane;
                    typedef float f32x2 __attribute__((ext_vector_type(2)));
                    *(f32x2*)ogk = (f32x2){k0, k1}; *(f32x2*)ogv = (f32x2){bflo(vpk), bfhi(vpk)};
                }
                *(unsigned*)(KG + (size_t)pos * 128 + 2 * lane) = pg8::cvt_pk_bf16(k0, k1);
                *(unsigned*)(VG + (size_t)pos * 128 + 2 * lane) = vpk;
            }
            {
                f32x4 scw[3];
#pragma unroll
                for (int k = 0; k < 3; ++k) scw[k] = *(const f32x4*)(inptr(I_SCW) + (l * 3 + k) * 256 + 4 * lane);
                float pr6[4][4];
#pragma unroll
                for (int t = 0; t < 4; ++t) { pr6[t][0] = bflo(ac[t].x) * bflo(ah[t].x); pr6[t][1] = bfhi(ac[t].x) * bfhi(ah[t].x); pr6[t][2] = bflo(ac[t].y) * bflo(ah[t].y); pr6[t][3] = bfhi(ac[t].y) * bfhi(ah[t].y); }
#pragma unroll
                for (int rr = 0; rr < 2; ++rr) {
                    float o[4]; const float b4[4] = {bflo(ab[rr].x), bfhi(ab[rr].x), bflo(ab[rr].y), bfhi(ab[rr].y)};
#pragma unroll
                    for (int e = 0; e < 4; ++e) o[e] = b4[e] * (scw[0][e] * pr6[rr][e] + scw[1][e] * pr6[rr + 1][e] + scw[2][e] * pr6[rr + 2][e]);
                    u32x2 w; w.x = pg8::cvt_pk_bf16(o[0], o[1]); w.y = pg8::cvt_pk_bf16(o[2], o[3]);
                    *(u32x2*)(CAT + (size_t)(row_b + rr) * D + 4 * lane) = w;
                }
            }
        }
        if (wave < 2) {
            const int id = tile * 2 + wave, b = id >> 8, p = id & 255;
            const size_t src = ((size_t)(b * 2 + l) * 256 + p);
            typedef float f32x2 __attribute__((ext_vector_type(2)));
            const f32x4 ck = *(const f32x4*)(inptr(I_CDK) + src * 256 + 4 * lane), cv = *(const f32x4*)(inptr(I_CDV) + src * 256 + 4 * lane);
            const f32x2 gkk = *(const f32x2*)(inptr(I_CGK) + src * 128 + 2 * lane), gvv = *(const f32x2*)(inptr(I_CGV) + src * 128 + 2 * lane);
            u32x2 w; w.x = pg8::cvt_pk_bf16(ck[0], ck[1]); w.y = pg8::cvt_pk_bf16(ck[2], ck[3]);
            *(u32x2*)((bf16_t*)(a.ws + WS_KDL) + (size_t)(b * S_LAT + p) * 256 + 4 * lane) = w;
            w.x = pg8::cvt_pk_bf16(cv[0], cv[1]); w.y = pg8::cvt_pk_bf16(cv[2], cv[3]);
            *(u32x2*)((bf16_t*)(a.ws + WS_VDL) + (size_t)(b * S_LAT + p) * 256 + 4 * lane) = w;
            *(unsigned*)((bf16_t*)(a.ws + WS_KGL) + (size_t)(b * S_LAT + p) * 128 + 2 * lane) = pg8::cvt_pk_bf16(gkk[0], gkk[1]);
            *(unsigned*)((bf16_t*)(a.ws + WS_VGL) + (size_t)(b * S_LAT + p) * 128 + 2 * lane) = pg8::cvt_pk_bf16(gvv[0], gvv[1]);
        }
        __syncthreads();
        {
            const int cp = tid & 127, rg = tid >> 7;
            unsigned ca[16], cgv[16];
#pragma unroll
            for (int i = 0; i < 16; ++i) { const int r = rg + 4 * i, tp = pos0 - 15 + r; ca[i] = 0u; cgv[i] = 0u;
                if (r < 62 && tp >= 0 && tp < seqlen) { const bf16_t* p2 = PROJ + (size_t)(row0 - 15 + r) * MIXIN; ca[i] = *(const unsigned*)(p2 + 1536 + 2 * cp); cgv[i] = *(const unsigned*)(p2 + 1792 + 2 * cp); } }
#pragma unroll
            for (int i = 0; i < 16; ++i) { const int r = rg + 4 * i;
                if (r < 62) { typedef float f32x2 __attribute__((ext_vector_type(2)));
                    const float u0 = bflo(ca[i]) * __builtin_amdgcn_rcpf(1.0f + __builtin_amdgcn_exp2f(-LOG2E * bflo(cgv[i]))), u1 = bfhi(ca[i]) * __builtin_amdgcn_rcpf(1.0f + __builtin_amdgcn_exp2f(-LOG2E * bfhi(cgv[i])));
                    *(f32x2*)(U + r * 256 + 2 * cp) = (f32x2){u0, u1}; } }
        }
        __syncthreads();
        {
            const int c = tid & 255, half = tid >> 8;
            float w[31], acc[16];
#pragma unroll
            for (int k = 0; k < 31; ++k) w[k] = inptr(I_CDWW)[(l * 31 + k) * 256 + c];
            const float bias = inptr(I_CDWB)[l * 256 + c];
#pragma unroll
            for (int o = 0; o < 16; ++o) acc[o] = bias;
#pragma unroll
            for (int i = 0; i < 46; ++i) { const float u = U[(16 * half + i) * 256 + c];
#pragma unroll
                for (int o = 0; o < 16; ++o) { const int k = i - o; if (k >= 0 && k < 31) acc[o] += w[k] * u; } }
#pragma unroll
            for (int o = 0; o < 16; ++o) VB[(16 * half + o) * 256 + c] = acc[o];
        }
        __syncthreads();
        const f32x4 lng = *(const f32x4*)(inptr(I_CLNG) + l * 256 + 4 * lane), lnb = *(const f32x4*)(inptr(I_CLNB) + l * 256 + 4 * lane);
#pragma unroll
        for (int rr = 0; rr < 4; ++rr) {
            const int rl = wave * 4 + rr, row = row0 + rl;
            f32x4 v = *(const f32x4*)(VB + rl * 256 + 4 * lane);
            const float mu = wave_sum((v[0] + v[1]) + (v[2] + v[3])) * (1.0f / 256.0f);
            v = v - mu;
            const float rstd = rsqrtf(wave_sum((v[0] * v[0] + v[1] * v[1]) + (v[2] * v[2] + v[3] * v[3])) * (1.0f / 256.0f) + EPS);
            const f32x4 y = v * rstd * lng + lnb;
            u32x2 w; w.x = pg8::cvt_pk_bf16(silu_f(y[0]), silu_f(y[1])); w.y = pg8::cvt_pk_bf16(silu_f(y[2]), silu_f(y[3]));
            *(u32x2*)(CAT + (size_t)row * D + 512 + 4 * lane) = w;
        }
        __syncthreads();
    }
}

constexpr int AT_KB = 64 * 144;
constexpr int AT_K0 = 0, AT_V0 = 2 * AT_KB, AT_XCH = 40960;
template <int DK>
__device__ __forceinline__ void attn_unit(unsigned char* lds, const Args& a, int l, bool is_diff, int hidx, int qrow0, const bf16_t* Kp, const bf16_t* Vp, int ldkv, int S) {
    const int tid = tid_now(), lane = tid & 63, wave = __builtin_amdgcn_readfirstlane(tid >> 6), sub = wave >> 2, wq = wave & 3, r32 = lane & 31, hi = lane >> 5;
    const int kcol = hidx * 64;
    const int kcsub = is_diff ? sub * 32 : 0;
    const bf16_t* Qp = is_diff ? (const bf16_t*)(a.ws + WS_QD) + hidx * 64 + sub * 32 : (const bf16_t*)(a.ws + WS_QG) + (2 * hidx + sub) * 64;
    const int qrow = qrow0 + wq * 32 + r32;
    bf16x8 qf[DK / 16];
#pragma unroll
    for (int d0 = 0; d0 < DK / 16; ++d0) qf[d0] = *(const bf16x8*)(Qp + (size_t)qrow * 256 + d0 * 16 + hi * 8);
    const int sr = tid & 63, sch = tid >> 6;
    const bf16_t* kg = Kp + (size_t)sr * ldkv + kcol + sch * 8; const bf16_t* vg = Vp + (size_t)sr * ldkv + kcol + sch * 8;
    const int o16 = sr & 15; const int vcol = 16 * (sr >> 4) + 8 * ((o16 >> 2) & 1) + (o16 & 3) + 4 * (o16 >> 3);
    u32x4 kreg = *(const u32x4*)kg, vreg = *(const u32x4*)vg;
    const int NT = S / 64;
    float m_run = 0.f, l_run = 0.f;
    f32x16 o0, o1;
#pragma unroll
    for (int r = 0; r < 16; ++r) { o0[r] = 0.f; o1[r] = 0.f; }
    for (int t = 0; t < NT; ++t) {
        unsigned char* kb = lds + AT_K0 + (t & 1) * AT_KB; unsigned char* vb = lds + AT_V0 + (t & 1) * AT_KB;
        *(u32x4*)(kb + sr * 144 + sch * 16) = kreg;
        {
            bf16_t* vt = (bf16_t*)vb + (sch * 8) * 72 + vcol;
            vt[0 * 72] = (bf16_t)(vreg.x & 0xffffu); vt[1 * 72] = (bf16_t)(vreg.x >> 16); vt[2 * 72] = (bf16_t)(vreg.y & 0xffffu); vt[3 * 72] = (bf16_t)(vreg.y >> 16);
            vt[4 * 72] = (bf16_t)(vreg.z & 0xffffu); vt[5 * 72] = (bf16_t)(vreg.z >> 16); vt[6 * 72] = (bf16_t)(vreg.w & 0xffffu); vt[7 * 72] = (bf16_t)(vreg.w >> 16);
        }
        __syncthreads();
        if (t + 1 < NT) { kreg = *(const u32x4*)(kg + (size_t)(t + 1) * 64 * ldkv); vreg = *(const u32x4*)(vg + (size_t)(t + 1) * 64 * ldkv); }
        f32x16 p0, p1;
        { const float nm = -m_run;
#pragma unroll
        for (int r = 0; r < 16; ++r) { p0[r] = nm; p1[r] = nm; } }
#pragma unroll
        for (int d0 = 0; d0 < DK / 16; ++d0) {
            const bf16x8 k0 = *(const bf16x8*)(kb + r32 * 144 + (kcsub + 16 * d0 + 8 * hi) * 2);
            const bf16x8 k1 = *(const bf16x8*)(kb + (32 + r32) * 144 + (kcsub + 16 * d0 + 8 * hi) * 2);
            p0 = __builtin_amdgcn_mfma_f32_32x32x16_bf16(k0, qf[d0], p0, 0, 0, 0);
            p1 = __builtin_amdgcn_mfma_f32_32x32x16_bf16(k1, qf[d0], p1, 0, 0, 0);
        }
        float mxa = fmaxf(fmaxf(p0[0], p0[1]), p1[0]), mxb = fmaxf(fmaxf(p0[2], p0[3]), p1[1]);
        mxa = fmaxf(fmaxf(mxa, p1[2]), p1[3]);
#pragma unroll
        for (int r = 4; r < 16; r += 4) { mxa = fmaxf(fmaxf(mxa, p0[r]), p0[r + 1]); mxb = fmaxf(fmaxf(mxb, p0[r + 2]), p0[r + 3]); mxa = fmaxf(fmaxf(mxa, p1[r]), p1[r + 1]); mxb = fmaxf(fmaxf(mxb, p1[r + 2]), p1[r + 3]); }
        float mx = fmaxf(mxa, mxb);
        mx = fmaxf(mx, __shfl_xor(mx, 32));
        if (__any(mx > 6.0f)) {
            const float dl = fmaxf(mx, 0.f); m_run += dl;
            const float alpha = __builtin_amdgcn_exp2f(-dl); l_run *= alpha;
#pragma unroll
            for (int r = 0; r < 16; ++r) { p0[r] -= dl; p1[r] -= dl; o0[r] *= alpha; o1[r] *= alpha; }
        }
        float ls = 0.f;
#pragma unroll
        for (int r = 0; r < 16; ++r) { p0[r] = __builtin_amdgcn_exp2f(p0[r]); p1[r] = __builtin_amdgcn_exp2f(p1[r]); ls += p0[r] + p1[r]; }
        l_run += ls;
        bf16x8 pk[4];
#pragma unroll
        for (int ks = 0; ks < 4; ++ks) {
            u32x4 w;
            if (ks < 2) { w.x = pg8::cvt_pk_bf16(p0[8 * ks + 0], p0[8 * ks + 1]); w.y = pg8::cvt_pk_bf16(p0[8 * ks + 2], p0[8 * ks + 3]); w.z = pg8::cvt_pk_bf16(p0[8 * ks + 4], p0[8 * ks + 5]); w.w = pg8::cvt_pk_bf16(p0[8 * ks + 6], p0[8 * ks + 7]); }
            else { const int b = 8 * (ks - 2); w.x = pg8::cvt_pk_bf16(p1[b + 0], p1[b + 1]); w.y = pg8::cvt_pk_bf16(p1[b + 2], p1[b + 3]); w.z = pg8::cvt_pk_bf16(p1[b + 4], p1[b + 5]); w.w = pg8::cvt_pk_bf16(p1[b + 6], p1[b + 7]); }
            pk[ks] = __builtin_bit_cast(bf16x8, w);
        }
#pragma unroll
        for (int ks = 0; ks < 4; ++ks) {
            const bf16x8 v0 = *(const bf16x8*)(vb + r32 * 144 + (16 * ks + 8 * hi) * 2);
            const bf16x8 v1 = *(const bf16x8*)(vb + (32 + r32) * 144 + (16 * ks + 8 * hi) * 2);
            o0 = __builtin_amdgcn_mfma_f32_32x32x16_bf16(v0, pk[ks], o0, 0, 0, 0);
            o1 = __builtin_amdgcn_mfma_f32_32x32x16_bf16(v1, pk[ks], o1, 0, 0, 0);
        }
    }
    const float lt = l_run + __shfl_xor(l_run, 32); const float inv = 1.0f / lt;
#pragma unroll
    for (int r = 0; r < 16; ++r) { o0[r] *= inv; o1[r] *= inv; }
    bf16_t* CAT = (bf16_t*)(a.ws + WS_CAT);
    if (is_diff) {
        float* XCH = (float*)(lds + AT_XCH);
        if (sub == 1) {
#pragma unroll
            for (int r = 0; r < 16; ++r) { XCH[(wq * 32 + r) * 64 + lane] = o0[r]; XCH[(wq * 32 + 16 + r) * 64 + lane] = o1[r]; }
        }
        __syncthreads();
        if (sub == 0) {
            float d1 = (lane < 32) ? inptr(I_LQ1)[l * 32 + lane] * inptr(I_LK1)[l * 32 + lane] : 0.f;
            float d2 = (lane < 32) ? inptr(I_LQ2)[l * 32 + lane] * inptr(I_LK2)[l * 32 + lane] : 0.f;
            const float lam_init = (l == 0) ? 0.2f : 0.35550907f;
            const float lam = __expf(wave_sum(d1)) - __expf(wave_sum(d2)) + lam_init;
            float ss = 0.f;
#pragma unroll
            for (int r = 0; r < 16; ++r) { o0[r] -= lam * XCH[(wq * 32 + r) * 64 + lane]; o1[r] -= lam * XCH[(wq * 32 + 16 + r) * 64 + lane]; ss += o0[r] * o0[r] + o1[r] * o1[r]; }
            ss += __shfl_xor(ss, 32);
            const float rs = rsqrtf(ss * (1.0f / 64.0f) + EPS) * (1.0f - lam_init);
            bf16_t* op = CAT + (size_t)qrow * D + 256 + hidx * 64;
#pragma unroll
            for (int g = 0; g < 4; ++g) {
                const int d = 8 * g + 4 * hi; const float* sl = inptr(I_SUBLN) + l * 64;
                u32x2 w0, w1;
                w0.x = pk2(o0[4 * g + 0] * rs * sl[d + 0], o0[4 * g + 1] * rs * sl[d + 1]); w0.y = pk2(o0[4 * g + 2] * rs * sl[d + 2], o0[4 * g + 3] * rs * sl[d + 3]);
                w1.x = pk2(o1[4 * g + 0] * rs * sl[32 + d + 0], o1[4 * g + 1] * rs * sl[32 + d + 1]); w1.y = pk2(o1[4 * g + 2] * rs * sl[32 + d + 2], o1[4 * g + 3] * rs * sl[32 + d + 3]);
                *(u32x2*)(op + d) = w0; *(u32x2*)(op + 32 + d) = w1;
            }
        }
    } else {
        bf16_t* op = CAT + (size_t)qrow * D + 768 + (2 * hidx + sub) * 64;
#pragma unroll
        for (int g = 0; g < 4; ++g) {
            const int d = 8 * g + 4 * hi;
            u32x2 w0, w1;
            w0.x = pk2(o0[4 * g + 0], o0[4 * g + 1]); w0.y = pk2(o0[4 * g + 2], o0[4 * g + 3]);
            w1.x = pk2(o1[4 * g + 0], o1[4 * g + 1]); w1.y = pk2(o1[4 * g + 2], o1[4 * g + 3]);
            *(u32x2*)(op + d) = w0; *(u32x2*)(op + 32 + d) = w1;
        }
    }
    __syncthreads();
}

__device__ __forceinline__ void attn_phase(const Args& a, unsigned char* lds, int l, int rep) {
    unsigned* ctr = (unsigned*)(a.ws + WS_CTL) + 64 * (1 + l + 2 * rep);
    unsigned* slot = (unsigned*)(lds + 131072);
    for (;;) {
        __syncthreads();
        if (threadIdx.x == 0) *slot = atomicAdd(ctr, 1u);
        __syncthreads();
        const int u = (int)*slot;
        if (u >= 384) break;
        bool is_diff, lat; int seq, qb, hidx;
        if (u < 64) { lat = true; is_diff = false; seq = u / 32; const int rem = u % 32; qb = rem >> 1; hidx = rem & 1; }
        else if (u < 192) { const int v = u - 64; lat = true; is_diff = true; seq = v / 64; const int rem = v % 64; qb = rem >> 2; hidx = rem & 3; }
        else if (u < 256) { const int v = u - 192; lat = false; is_diff = false; seq = v >> 2; const int rem = v & 3; qb = rem >> 1; hidx = rem & 1; }
        else { const int v = u - 256; lat = false; is_diff = true; seq = v >> 3; const int rem = v & 7; qb = rem >> 2; hidx = rem & 3; }
        const int qrow0 = lat ? CTX_TOK + seq * SEQ_L + qb * 128 : seq * SEQ_C + qb * 128;
        const int S = lat ? S_LAT : SEQ_C;
        if (is_diff) {
            const bf16_t* Kp = lat ? (const bf16_t*)(a.ws + WS_KDL) + (size_t)seq * S_LAT * 256 : (const bf16_t*)(a.ws + WS_KDC) + (size_t)seq * SEQ_C * 256;
            const bf16_t* Vp = lat ? (const bf16_t*)(a.ws + WS_VDL) + (size_t)seq * S_LAT * 256 : (const bf16_t*)(a.ws + WS_VDC) + (size_t)seq * SEQ_C * 256;
            attn_unit<32>(lds, a, l, true, hidx, qrow0, Kp, Vp, 256, S);
        } else {
            const bf16_t* Kp = lat ? (const bf16_t*)(a.ws + WS_KGL) + (size_t)seq * S_LAT * 128 : (const bf16_t*)(a.ws + WS_KGC) + (size_t)seq * SEQ_C * 128;
            const bf16_t* Vp = lat ? (const bf16_t*)(a.ws + WS_VGL) + (size_t)seq * S_LAT * 128 : (const bf16_t*)(a.ws + WS_VGC) + (size_t)seq * SEQ_C * 128;
            attn_unit<64>(lds, a, l, false, hidx, qrow0, Kp, Vp, 128, S);
        }
    }
}

#define XB_TMO      128
#define XB_XCNT(j)  (256  + 64 * (j))
#define XB_XSUB(j)  (1280 + 64 * (j))
#define XB_XGEN(j)  (2304 + 64 * (j))
#define XB_TOP      3328
#define XB_TOPGEN   3392
#define XCD_BAR_WORDS 3456
#define XB_SPIN_CAP (1u << 18)
__device__ __forceinline__ unsigned xb_ld(unsigned* p)              { return __hip_atomic_load(p, __ATOMIC_RELAXED, __HIP_MEMORY_SCOPE_AGENT); }
__device__ __forceinline__ unsigned xb_add(unsigned* p, unsigned v) { return __hip_atomic_fetch_add(p, v, __ATOMIC_RELAXED, __HIP_MEMORY_SCOPE_AGENT); }
__device__ __forceinline__ unsigned xb_xcc_id() { return (unsigned)__builtin_amdgcn_s_getreg((3 << 11) | 20) & 0xFu; }
#define XB_SPIN(cond, bar) do { unsigned _sp = 0; while (cond) { __builtin_amdgcn_s_sleep(1); \
    if ((++_sp & 255u) == 0u) { if (xb_ld(&(bar)[XB_TMO])) break; if (_sp > XB_SPIN_CAP) { atomicAdd(&(bar)[XB_TMO], 1u); break; } } } } while (0)
struct XcdBarrier { unsigned* bar; unsigned x; volatile LAS unsigned* st; };
__device__ __forceinline__ XcdBarrier xcd_barrier_post(unsigned* bar, volatile LAS unsigned* st) {
    XcdBarrier b; b.bar = bar; b.x = xb_xcc_id(); b.st = st;
    if (threadIdx.x == 0) (void)xb_add(&bar[XB_XCNT(b.x)], 1u);
    return b;
}
__device__ __forceinline__ void xcd_barrier_complete(unsigned* bar, unsigned x, unsigned& nloc, unsigned& nx) {
    const unsigned G = gridDim.x * gridDim.y * gridDim.z;
    unsigned sum, cnt, mine, sp = 0u;
    for (;;) {
        sum = 0u; cnt = 0u; mine = 0u;
#pragma unroll 1
        for (unsigned j = 0; j < 16; ++j) { const unsigned c = xb_ld(&bar[XB_XCNT(j)]); sum += c; cnt += (c > 0u) ? 1u : 0u; mine = (j == x) ? c : mine; }
        if (sum == G) break;
        __builtin_amdgcn_s_sleep(1);
        if ((++sp & 255u) == 0u) { if (xb_ld(&bar[XB_TMO])) break; if (sp > XB_SPIN_CAP) { atomicAdd(&bar[XB_TMO], 1u); break; } }
    }
    nloc = mine > 0u ? mine : 1u; nx = cnt > 0u ? cnt : 1u;
}
__device__ __forceinline__ void xcd_barrier(const XcdBarrier& b) {
    asm volatile("s_waitcnt vmcnt(0)" ::: "memory");
    __syncthreads();
    if (threadIdx.x == 0) {
        unsigned* bar = b.bar;
        __builtin_amdgcn_s_waitcnt(0);
        unsigned nloc = b.st[0], nx = b.st[1];
        if (nloc == 0u) { xcd_barrier_complete(bar, b.x, nloc, nx); b.st[0] = nloc; b.st[1] = nx; }
        const unsigned old = xb_add(&bar[XB_XSUB(b.x)], 1u);
        const unsigned gen = old / nloc;
        if (old + 1u == (gen + 1u) * nloc) {
            __builtin_amdgcn_fence(__ATOMIC_RELEASE, "agent");
            asm volatile("s_waitcnt vmcnt(0)" ::: "memory");
            const unsigned og = xb_add(&bar[XB_TOP], 1u);
            const unsigned tg = og / nx;
            if (og + 1u == (tg + 1u) * nx) xb_add(&bar[XB_TOPGEN], 1u);
            else XB_SPIN(xb_ld(&bar[XB_TOPGEN]) == tg, bar);
            __builtin_amdgcn_fence(__ATOMIC_ACQUIRE, "agent");
            xb_add(&bar[XB_XGEN(b.x)], 1u);
            asm volatile("s_waitcnt vmcnt(0)" ::: "memory");
        } else {
            XB_SPIN(xb_ld(&bar[XB_XGEN(b.x)]) == gen, bar);
            __builtin_amdgcn_fence(__ATOMIC_ACQUIRE, "agent");
            asm volatile("s_waitcnt vmcnt(0)" ::: "memory");
        }
    }
    __syncthreads();
}

__global__ void __launch_bounds__(512, 2) fwd_kernel(Args a) {
    extern __shared__ __attribute__((aligned(16))) unsigned char lds[];
    cg::grid_group grid = cg::this_grid();
    const int G = gridDim.x, bx = blockIdx.x;
    const int vcu = (G % 8 == 0) ? (bx % 8) * (G / 8) + bx / 8 : bx;
    const int NGW = G * 8;
    LAS unsigned char* lds3 = (LAS unsigned char*)lds;
    int ph = 0;
    if (threadIdx.x < 16) ((LAS unsigned*)(lds3 + 131072 + 12288))[threadIdx.x] = 0u;
    __syncthreads();
    XcdBarrier bar = xcd_barrier_post((unsigned*)(a.ws + WS_CTL) + 1024, (volatile LAS unsigned*)(lds3 + 131072 + 12288));
    if (a.ph_hi == -12345) grid.sync();
#define RUN(k) (a.ph_lo <= (k) && (k) < a.ph_hi)
#define SEAM() do { if (a.ph_lo <= ph && ph + 1 < a.ph_hi) { for (int rp_ = 0; rp_ < NREP(1); ++rp_) xcd_barrier(bar); } ++ph; } while (0)
#define REP(k) _Pragma("unroll 1") for (int rp_ = 0; rp_ < NREP(k); ++rp_)

    if (RUN(ph)) { REP(2) p0_prologue(a, lds, vcu, NGW); }
    SEAM();
    if (RUN(ph)) mod_finalize(a, vcu, G);
    SEAM();
    for (int l = 0; l < 2; ++l) {
        unsigned char* wl = a.ws + WS_W + (size_t)l * WL;
        if (l == 0) { if (RUN(ph)) norm_phase(a, lds, vcu, NGW, true, false, 0, 0, true, 0, 0); SEAM(); }
        if (RUN(ph)) { pg8::Gemm g{(const bf16_t*)(a.ws + WS_H), (const bf16_t*)(wl + WO_GU1), D}; pg8::StaticOrder S; S.init(TOK, NGU, 1, G, bx, D);
            pg8::EpiSwiGLU E{(bf16_t*)(a.ws + WS_ACT)}; REP(5) pg8::gemm_phase(lds3, g, S, E); }
        SEAM();
        if (RUN(ph)) { pg8::Gemm g{(const bf16_t*)(a.ws + WS_ACT), (const bf16_t*)(wl + WO_D1), DFF}; pg8::StaticOrder S; S.init(TOK, D, 2, G, bx, DFF / 2);
            pg8::EpiBf16 E{(bf16_t*)(a.ws + WS_Y), D, (size_t)TOK * D}; REP(7) pg8::gemm_phase(lds3, g, S, E); }
        SEAM();
        if (RUN(ph)) { if (PROBE == 6) { for (int rp_ = 0; rp_ < 2; ++rp_) norm_phase(a, lds, vcu, NGW, false, true, l, 0, true, l, 1, true); } norm_phase(a, lds, vcu, NGW, l == 0, true, l, 0, true, l, 1); }
        SEAM();
        if (RUN(ph)) { pg8::Gemm g{(const bf16_t*)(a.ws + WS_H), (const bf16_t*)(wl + WO_MI), D}; pg8::MixInOrder S; S.init(G, bx);
            pg8::EpiMixIn E{(bf16_t*)(a.ws + WS_ACT), (bf16_t*)(a.ws + WS_Y)}; REP(8) pg8::gemm_phase(lds3, g, S, E); }
        SEAM();
        if (RUN(ph)) { REP(4) mix_prep(a, lds, l); }
        SEAM();
        if (RUN(ph)) { REP(3) attn_phase(a, lds, l, rp_); }
        SEAM();
        if (RUN(ph)) { pg8::Gemm g{(const bf16_t*)(a.ws + WS_CAT), (const bf16_t*)(wl + WO_MO), D}; pg8::StaticOrder S; S.init(TOK, D, 2, G, bx, D / 2);
            pg8::EpiBf16 E{(bf16_t*)(a.ws + WS_Y), D, (size_t)TOK * D}; REP(7) pg8::gemm_phase(lds3, g, S, E); }
        SEAM();
        if (RUN(ph)) norm_phase(a, lds, vcu, NGW, false, true, l, 1, true, l, 2);
        SEAM();
        if (RUN(ph)) { pg8::Gemm g{(const bf16_t*)(a.ws + WS_H), (const bf16_t*)(wl + WO_GU2), D}; pg8::StaticOrder S; S.init(TOK, NGU, 1, G, bx, D);
            pg8::EpiSwiGLU E{(bf16_t*)(a.ws + WS_ACT)}; REP(5) pg8::gemm_phase(lds3, g, S, E); }
        SEAM();
        if (RUN(ph)) { pg8::Gemm g{(const bf16_t*)(a.ws + WS_ACT), (const bf16_t*)(wl + WO_D2), DFF}; pg8::StaticOrder S; S.init(TOK, D, 2, G, bx, DFF / 2);
            pg8::EpiBf16 E{(bf16_t*)(a.ws + WS_Y), D, (size_t)TOK * D}; REP(7) pg8::gemm_phase(lds3, g, S, E); }
        SEAM();
        if (RUN(ph)) norm_phase(a, lds, vcu, NGW, false, true, l, 2, l == 0, 1, 0);
        SEAM();
    }
#undef RUN
#undef SEAM
}

extern "C" void kernel_launch(void* const* d_in, const int* in_sizes, int n_in, void* d_out, int out_size, void* d_ws, size_t ws_size, hipStream_t stream) {
    static int grid = 0;
    if (grid == 0) {
        if (n_in != 33 || ws_size < WS_END) { fprintf(stderr, "kernel_launch: unexpected n_in %d / ws_size %zu\n", n_in, ws_size); grid = -1; return; }
        int dev = 0, cus = 0, per_cu = 0;
        (void)hipGetDevice(&dev);
        (void)hipDeviceGetAttribute(&cus, hipDeviceAttributeMultiprocessorCount, dev);
        if (hipFuncSetAttribute((const void*)fwd_kernel, hipFuncAttributeMaxDynamicSharedMemorySize, LDS_BYTES) != hipSuccess) { fprintf(stderr, "kernel_launch: hipFuncSetAttribute failed\n"); grid = -1; return; }
        if (hipOccupancyMaxActiveBlocksPerMultiprocessor(&per_cu, (const void*)fwd_kernel, 512, LDS_BYTES) != hipSuccess || per_cu < 1) { fprintf(stderr, "kernel_launch: occupancy query gave %d\n", per_cu); per_cu = 1; }
        (void)hipGetLastError();
        grid = cus * 1;
    }
    if (grid < 0) return;
    (void)hipMemsetAsync((char*)d_ws + WS_CTL, 0, 65536, stream);
    Args a{};
    for (int i = 0; i < 33; ++i) a.in[i] = (const float*)d_in[i];
    a.out = (float*)d_out; a.ws = (unsigned char*)d_ws; a.ph_lo = 0; a.ph_hi = 1000;
    void* args[] = {&a};
    hipError_t e = hipLaunchCooperativeKernel((const void*)fwd_kernel, dim3(grid), dim3(512), args, LDS_BYTES, stream);
    if (e != hipSuccess) fprintf(stderr, "kernel_launch: cooperative launch failed: %s (grid %d)\n", hipGetErrorString(e), grid);
}
```

```cpp
#include <hip/hip_runtime.h>
#include <hip/hip_cooperative_groups.h>
#include <cstdio>
#include <cstdint>
namespace cg = cooperative_groups;
#ifndef PROBE
#define PROBE 0
#endif
#define NREP(k) ((PROBE == (k)) ? 3 : 1)

typedef unsigned short bf16_t;
typedef short bf16x8 __attribute__((ext_vector_type(8)));
typedef float f32x4 __attribute__((ext_vector_type(4)));
typedef float f32x16 __attribute__((ext_vector_type(16)));
typedef unsigned u32x4 __attribute__((ext_vector_type(4)));
typedef unsigned u32x2 __attribute__((ext_vector_type(2)));
#define LAS __attribute__((address_space(3)))

constexpr int D = 1024, TOK = 8192, CTX_TOK = 4096, DFF = 2816, NGU = 5632, MIXIN = 2560;
constexpr int SEQ_C = 256, SEQ_L = 2048, S_LAT = 2304, NMOD = 9216;
constexpr float EPS = 1e-6f;
constexpr float LOG2E = 1.4426950408889634f;

constexpr size_t MiB = 1u << 20;
constexpr size_t WS_CTL = 0;
constexpr size_t WS_MODP = 64 * 1024;
constexpr size_t WS_W = 2 * MiB, WL = 40 * MiB;
constexpr size_t WO_GU1 = 0, WO_D1 = 11 * MiB, WO_GU2 = 16 * MiB + 512 * 1024, WO_D2 = 27 * MiB + 512 * 1024, WO_MI = 33 * MiB, WO_MO = 38 * MiB;
constexpr size_t WS_H = 82 * MiB, WS_CAT = 98 * MiB, WS_ACT = 114 * MiB, WS_Y = 158 * MiB;
constexpr size_t WS_QD = 222 * MiB, WS_QG = 226 * MiB;
constexpr size_t WS_KDC = 230 * MiB, WS_VDC = 232 * MiB, WS_KGC = 234 * MiB, WS_VGC = 235 * MiB;
constexpr size_t WS_KDL = 236 * MiB, WS_VDL = 239 * MiB, WS_KGL = 242 * MiB, WS_VGL = 244 * MiB, WS_TAB = 246 * MiB, WS_END = 247 * MiB;

constexpr int LDS_BYTES = 131072 + 12288 + 64;

__device__ __forceinline__ float wave_sum(float v) {
#pragma unroll
    for (int o = 1; o < 64; o <<= 1) v += __shfl_xor(v, o);
    return v;
}
__device__ __forceinline__ unsigned f2bf(float f) { unsigned u = __builtin_bit_cast(unsigned, f); return (u + 0x7fffu + ((u >> 16) & 1u)) >> 16; }
typedef float f32x2_cv __attribute__((ext_vector_type(2))); typedef __bf16 bf16x2_cv __attribute__((ext_vector_type(2)));
__device__ __forceinline__ unsigned pk2(float lo, float hi) { f32x2_cv v = {lo, hi}; bf16x2_cv b = __builtin_convertvector(v, bf16x2_cv); return __builtin_bit_cast(unsigned, b); }
__device__ __forceinline__ float bf2f(bf16_t h) { return __builtin_bit_cast(float, (unsigned)h << 16); }
__device__ __forceinline__ float silu_f(float v) { return v * __builtin_amdgcn_rcpf(1.0f + __builtin_amdgcn_exp2f(-1.4426950408889634f * v)); }
__device__ __forceinline__ int tid_now() { int t = threadIdx.x; asm volatile("" : "+v"(t)); return t; }

namespace pg8 {
constexpr int BM = 256, BK = 64, HALF = 128, HTB = HALF * BK * 2, NXCD = 8, WGM = 8;
__host__ __device__ __forceinline__ int lds_byte(int r, int c) { const int st = (r >> 4) * 2 + (c >> 5), rr = r & 15, cc = c & 31, ob = rr * 64 + cc * 2; return st * 1024 + (ob ^ (((ob >> 9) & 1) << 5)); }
__host__ __device__ __forceinline__ void stage_rc(int b, int& R, int& C) { const int st = b / 1024, sb = b % 1024, swz = sb ^ (((sb >> 9) & 1) << 5); R = (st >> 1) * 16 + swz / 64; C = (st & 1) * 32 + (swz % 64) / 2; }
__host__ __device__ __forceinline__ int perm32(int rho) { const int n = rho >> 4, i = rho & 15; return 8 * (i >> 2) + 4 * n + (i & 3); }

struct Unit { int pm, pn, ks, nt, koff; };
struct Gemm { const bf16_t* A; const bf16_t* Bt; int ld; };

struct StaticOrder {
    int nM, nN, nNr, nwg, G, c, Kloop;
    __device__ void init(int M, int N, int KS, int G_, int c_, int Kloop_) { nM = M / BM; nNr = N / BM; nN = nNr * KS; nwg = nM * nN; G = G_; c = c_; Kloop = Kloop_; }
    __device__ bool next(int i, Unit& u) const {
        const long L = (long)i * G + c; if (L >= nwg) return false;
        int wgid = (int)L; { const int q = nwg / NXCD, r = nwg % NXCD, xcd = wgid % NXCD, off = wgid / NXCD; wgid = (xcd < r ? xcd * (q + 1) : r * (q + 1) + (xcd - r) * q) + off; }
        const int nig = WGM * nN, gid = wgid / nig, fm = gid * WGM, gsz = (nM - fm) < WGM ? (nM - fm) : WGM;
        u.pm = fm + ((wgid % nig) % gsz); const int pv = (wgid % nig) / gsz; u.pn = pv % nNr; u.ks = pv / nNr; u.nt = Kloop / BK; u.koff = u.ks * Kloop * 2; return true;
    }
};

struct MixInOrder {
    StaticOrder S8; int G, c;
    __device__ void init(int G_, int c_) { S8.init(TOK, 2048, 1, G_, c_, D); G = G_; c = c_; }
    __device__ bool next(int i, Unit& u) const {
        const long L = (long)i * G + c;
        if (L < 256) return S8.next(i, u);
        if (L >= 512) return false;
        const int idx = (int)L - 256, r = idx & 7; u.pm = idx >> 3; u.pn = 8 + (r & 1); u.ks = r >> 1; u.nt = 4; u.koff = u.ks * 512; return true;
    }
};

__device__ __forceinline__ unsigned cvt_pk_bf16(float lo, float hi) { f32x2_cv v = {lo, hi}; bf16x2_cv b = __builtin_convertvector(v, bf16x2_cv); return __builtin_bit_cast(unsigned, b); }

struct EpiBf16 {
    static constexpr bool PERM = true;
    bf16_t* O; int ldc; size_t ks_stride;
    __device__ __forceinline__ void operator()(const f32x4 (&acc)[2][2][4][2], const Unit& u, int wr, int wc, int fr, int fq) const {
        bf16_t* Ob = O + (size_t)u.ks * ks_stride;
        const int row0 = u.pm * BM + wr * 64 + fr; const int col0 = u.pn * BM + wc * 32 + 8 * fq;
#pragma unroll
        for (int ai = 0; ai < 2; ++ai)
#pragma unroll
            for (int m = 0; m < 4; ++m) { bf16_t* rowp = Ob + (size_t)(row0 + ai * HALF + m * 16) * ldc + col0;
#pragma unroll
                for (int bj = 0; bj < 2; ++bj) { const f32x4 v0 = acc[ai][bj][m][0], v1 = acc[ai][bj][m][1];
                    u32x4 w; w.x = cvt_pk_bf16(v0[0], v0[1]); w.y = cvt_pk_bf16(v0[2], v0[3]); w.z = cvt_pk_bf16(v1[0], v1[1]); w.w = cvt_pk_bf16(v1[2], v1[3]);
                    *(u32x4*)(rowp + bj * HALF) = w; } }
    }
};
struct EpiMixIn {
    static constexpr bool PERM = true;
    bf16_t* PROJ; bf16_t* PART;
    __device__ __forceinline__ void operator()(const f32x4 (&acc)[2][2][4][2], const Unit& u, int wr, int wc, int fr, int fq) const {
        const bool part = u.pn >= 8;
        bf16_t* Ob = part ? PART + (size_t)u.ks * TOK * 512 : PROJ; const int ldc = part ? 512 : MIXIN;
        const int row0 = u.pm * BM + wr * 64 + fr; const int col0 = (part ? u.pn - 8 : u.pn) * BM + wc * 32 + 8 * fq;
#pragma unroll
        for (int ai = 0; ai < 2; ++ai)
#pragma unroll
            for (int m = 0; m < 4; ++m) { bf16_t* rowp = Ob + (size_t)(row0 + ai * HALF + m * 16) * ldc + col0;
#pragma unroll
                for (int bj = 0; bj < 2; ++bj) { const f32x4 v0 = acc[ai][bj][m][0], v1 = acc[ai][bj][m][1];
                    u32x4 w; w.x = cvt_pk_bf16(v0[0], v0[1]); w.y = cvt_pk_bf16(v0[2], v0[3]); w.z = cvt_pk_bf16(v1[0], v1[1]); w.w = cvt_pk_bf16(v1[2], v1[3]);
                    *(u32x4*)(rowp + bj * HALF) = w; } }
    }
};
struct EpiSwiGLU {
    static constexpr bool PERM = true;
    bf16_t* O;
    __device__ __forceinline__ void operator()(const f32x4 (&acc)[2][2][4][2], const Unit& u, int wr, int wc, int fr, int fq) const {
        const int row0 = u.pm * BM + wr * 64 + fr; const int col0 = u.pn * HALF + wc * 32 + 8 * fq;
#pragma unroll
        for (int ai = 0; ai < 2; ++ai)
#pragma unroll
            for (int m = 0; m < 4; ++m) { bf16_t* rowp = O + (size_t)(row0 + ai * HALF + m * 16) * DFF + col0;
                const f32x4 g0 = acc[ai][0][m][0], g1 = acc[ai][0][m][1], u0 = acc[ai][1][m][0], u1 = acc[ai][1][m][1];
                float r[8];
#pragma unroll
                for (int i = 0; i < 4; ++i) { r[i] = silu_f(g0[i]) * u0[i]; r[4 + i] = silu_f(g1[i]) * u1[i]; }
                u32x4 w; w.x = cvt_pk_bf16(r[0], r[1]); w.y = cvt_pk_bf16(r[2], r[3]); w.z = cvt_pk_bf16(r[4], r[5]); w.w = cvt_pk_bf16(r[6], r[7]);
                *(u32x4*)rowp = w; }
    }
};
struct EpiF32 {
    static constexpr bool PERM = false;
    float* O; int ldc; size_t ks_stride;
    __device__ __forceinline__ void operator()(const f32x4 (&acc)[2][2][4][2], const Unit& u, int wr, int wc, int fr, int fq) const {
        float* base = O + (size_t)u.ks * ks_stride;
        const int row0 = u.pm * BM + wr * 64 + fr; const int col0 = u.pn * BM + wc * 32 + 4 * fq;
#pragma unroll
        for (int ai = 0; ai < 2; ++ai)
#pragma unroll
            for (int m = 0; m < 4; ++m) { float* rowp = base + (size_t)(row0 + ai * HALF + m * 16) * ldc + col0;
#pragma unroll
                for (int bj = 0; bj < 2; ++bj)
#pragma unroll
                    for (int n = 0; n < 2; ++n) *(f32x4*)(rowp + bj * HALF + n * 16) = acc[ai][bj][m][n]; }
    }
};

template <class Epi, class Sched>
__device__ __forceinline__ void gemm_phase(LAS unsigned char* lds, const Gemm g, const Sched& S, const Epi& E) {
    const int tid = tid_now(), wid = __builtin_amdgcn_readfirstlane(tid >> 6), lane = tid & 63, wr = wid >> 2, wc = wid & 3, fr = lane & 15, fq = lane >> 4;
    const int K = g.ld;
    unsigned voffA[2], voffB[2];
#pragma unroll
    for (int i = 0; i < 2; ++i) { int R, C; stage_rc(tid * 16 + i * 8192, R, C); const int Rb = Epi::PERM ? ((R & ~31) + perm32(R & 31)) : R;
        voffA[i] = (unsigned)(R * K + C) * 2u; voffB[i] = (unsigned)(Rb * K + C) * 2u; }
    const size_t kstep = (size_t)(BK * 2);
    const size_t hstep = (size_t)HALF * K * 2;
    const size_t tstep = 2 * hstep;
    const unsigned ldsw = (unsigned)wid * 1024u;
    const int aoff = lds_byte(wr * 64 + fr, fq * 8), boff = lds_byte(wc * 32 + fr, fq * 8);
#define PG8_SA(b, h) (((b) * 2 + (h)) * HTB)
#define PG8_SB(b, h) ((4 + (b) * 2 + (h)) * HTB)
#define PG8_STAGE(bufoff, gbase, voff) do { _Pragma("unroll") for (int _i = 0; _i < 2; ++_i) \
        __builtin_amdgcn_global_load_lds((const unsigned*)((const char*)(gbase) + (voff)[_i]), (LAS unsigned*)(lds + (bufoff) + ldsw + _i * 8192), 16, 0, 0); } while (0)
#define PG8_LDA(dst, b, h) do { _Pragma("unroll") for (int m = 0; m < 4; ++m) _Pragma("unroll") for (int k = 0; k < 2; ++k) dst[m][k] = *(const LAS bf16x8*)(lds + PG8_SA(b, h) + aoff + m * 2048 + k * 1024); } while (0)
#define PG8_LDB(dst, b, h) do { _Pragma("unroll") for (int n = 0; n < 2; ++n) _Pragma("unroll") for (int k = 0; k < 2; ++k) dst[n][k] = *(const LAS bf16x8*)(lds + PG8_SB(b, h) + boff + n * 2048 + k * 1024); } while (0)
#define PG8_MMA(ai, bj, At, Bt) do { __builtin_amdgcn_s_setprio(1); _Pragma("unroll") for (int m = 0; m < 4; ++m) _Pragma("unroll") for (int n = 0; n < 2; ++n) _Pragma("unroll") for (int k = 0; k < 2; ++k) \
        acc[ai][bj][m][n] = __builtin_amdgcn_mfma_f32_16x16x32_bf16(Bt[n][k], At[m][k], acc[ai][bj][m][n], 0, 0, 0); __builtin_amdgcn_s_setprio(0); } while (0)
#define PG8_WAIT_V(n) asm volatile("s_waitcnt vmcnt(" #n ")" ::: "memory")
#define PG8_WAIT_L(n) asm volatile("s_waitcnt lgkmcnt(" #n ")" ::: "memory")
#define PG8_BAR __builtin_amdgcn_s_barrier()
#define PG8_SCHED __builtin_amdgcn_sched_barrier(0)
    Unit cur, nxt; int ui = 0;
    if (!S.next(0, cur)) return;
    f32x4 acc[2][2][4][2];
#pragma unroll
    for (int a = 0; a < 2; ++a)
#pragma unroll
        for (int b = 0; b < 2; ++b)
#pragma unroll
            for (int m = 0; m < 4; ++m)
#pragma unroll
                for (int n = 0; n < 2; ++n) acc[a][b][m][n] = (f32x4){0.f, 0.f, 0.f, 0.f};
    bf16x8 At[4][2], B0[2][2], B1[2][2];
    const char* cA = (const char*)g.A + (size_t)cur.pm * tstep + (size_t)cur.koff; const char* cB = (const char*)g.Bt + (size_t)cur.pn * tstep + (size_t)cur.koff;
    PG8_STAGE(PG8_SB(0, 0), cB, voffB); PG8_STAGE(PG8_SB(0, 1), cB + hstep, voffB); PG8_STAGE(PG8_SA(0, 0), cA, voffA); PG8_STAGE(PG8_SA(0, 1), cA + hstep, voffA);
    if (wr == 1) PG8_BAR;
    PG8_WAIT_V(2); PG8_BAR;
    PG8_STAGE(PG8_SB(1, 0), cB + kstep, voffB); PG8_STAGE(PG8_SA(1, 0), cA + kstep, voffA); PG8_STAGE(PG8_SB(1, 1), cB + hstep + kstep, voffB);
    PG8_WAIT_V(6); PG8_BAR;
    for (;;) {
        const bool has_next = S.next(ui + 1, nxt);
        const char* nA = has_next ? (const char*)g.A + (size_t)nxt.pm * tstep + (size_t)nxt.koff : cA; const char* nB = has_next ? (const char*)g.Bt + (size_t)nxt.pn * tstep + (size_t)nxt.koff : cB;
        const int nt = cur.nt;
        for (int t = 0; t < nt; t += 2) {
            const bool last = (t == nt - 2);
            const char* a1 = cA + (size_t)(t + 1) * kstep;
            const char* a2 = last ? nA : cA + (size_t)(t + 2) * kstep; const char* b2 = last ? nB : cB + (size_t)(t + 2) * kstep;
            const char* a3 = a2 + kstep; const char* b3 = b2 + kstep;
            PG8_LDB(B0, 0, 0); PG8_LDB(B1, 0, 1); PG8_SCHED; PG8_LDA(At, 0, 0); PG8_STAGE(PG8_SA(1, 1), a1 + hstep, voffA);
            PG8_WAIT_V(8); PG8_WAIT_L(0); PG8_BAR; PG8_MMA(0, 0, At, B0); PG8_MMA(0, 1, At, B1); PG8_BAR; PG8_SCHED;
            PG8_LDA(At, 0, 1); PG8_STAGE(PG8_SB(0, 0), b2, voffB); PG8_STAGE(PG8_SB(0, 1), b2 + hstep, voffB); PG8_STAGE(PG8_SA(0, 0), a2, voffA);
            PG8_WAIT_V(8); PG8_WAIT_L(0); PG8_BAR; PG8_MMA(1, 0, At, B0); PG8_MMA(1, 1, At, B1); PG8_BAR; PG8_SCHED;
            PG8_LDB(B0, 1, 0); PG8_LDB(B1, 1, 1); PG8_SCHED; PG8_LDA(At, 1, 0); PG8_STAGE(PG8_SA(0, 1), a2 + hstep, voffA);
            PG8_WAIT_V(8); PG8_WAIT_L(0); PG8_BAR; PG8_MMA(0, 0, At, B0); PG8_MMA(0, 1, At, B1); PG8_BAR; PG8_SCHED;
            PG8_LDA(At, 1, 1); PG8_STAGE(PG8_SB(1, 0), b3, voffB); PG8_STAGE(PG8_SB(1, 1), b3 + hstep, voffB); PG8_STAGE(PG8_SA(1, 0), a3, voffA);
            PG8_WAIT_V(8); PG8_WAIT_L(0); PG8_BAR; PG8_MMA(1, 0, At, B0); PG8_MMA(1, 1, At, B1); PG8_BAR; PG8_SCHED;
        }
        if (wr == 0) PG8_BAR;
        E(acc, cur, wr, wc, fr, fq);
        if (!has_next) break;
#pragma unroll
        for (int a = 0; a < 2; ++a)
#pragma unroll
            for (int b = 0; b < 2; ++b)
#pragma unroll
                for (int m = 0; m < 4; ++m)
#pragma unroll
                    for (int n = 0; n < 2; ++n) acc[a][b][m][n] = (f32x4){0.f, 0.f, 0.f, 0.f};
        cur = nxt; cA = nA; cB = nB; ++ui;
        if (wr == 1) PG8_BAR;
    }
    PG8_WAIT_V(0);
    PG8_BAR;
#undef PG8_SA
#undef PG8_SB
#undef PG8_STAGE
#undef PG8_LDA
#undef PG8_LDB
#undef PG8_MMA
#undef PG8_WAIT_V
#undef PG8_WAIT_L
#undef PG8_BAR
#undef PG8_SCHED
}
}

struct Args { const float* in[33]; float* out; unsigned char* ws; int ph_lo, ph_hi; };
enum { I_XP = 0, I_XS, I_CDK, I_CDV, I_CGK, I_CGV, I_C, I_CCTX, I_WADA, I_BADA, I_NPRE, I_NPOST, I_F1G, I_F1U, I_F1D, I_F2G, I_F2U, I_F2D,
       I_WMI, I_WMO, I_SCW, I_LQ1, I_LK1, I_LQ2, I_LK2, I_SUBLN, I_CDWW, I_CDWB, I_CLNG, I_CLNB, I_CPW, I_QNORM, I_KNORM };

__device__ __forceinline__ const float* inptr(int i) {
    typedef const char __attribute__((address_space(4)))* kptr_t;
    kptr_t kp = (kptr_t)__builtin_amdgcn_kernarg_segment_ptr();
    unsigned off = 8u * (unsigned)i; asm volatile("" : "+s"(off));
    return *(const float* const __attribute__((address_space(4)))*)(kp + off);
}
__device__ __forceinline__ void tr_item(const float* W, int ldw, bf16_t* WT, int ldt, int k0, int n0, int orow0, float* scr, int lane) {
    f32x4 v[8];
    const int lr = lane >> 3, lc = (lane & 7) * 4;
#pragma unroll
    for (int i = 0; i < 8; ++i) v[i] = *(const f32x4*)(W + (size_t)(k0 + 8 * i + lr) * ldw + n0 + lc);
#pragma unroll
    for (int i = 0; i < 8; ++i) { float* d = scr + (8 * i + lr) * 33 + lc; d[0] = v[i][0]; d[1] = v[i][1]; d[2] = v[i][2]; d[3] = v[i][3]; }
    asm volatile("s_waitcnt lgkmcnt(0)" ::: "memory");
    const int c = lane & 7;
#pragma unroll
    for (int j = 0; j < 4; ++j) { const int n = (lane >> 3) + 8 * j; const float* s = scr + (8 * c) * 33 + n;
        u32x4 o; o.x = pk2(s[0 * 33], s[1 * 33]); o.y = pk2(s[2 * 33], s[3 * 33]); o.z = pk2(s[4 * 33], s[5 * 33]); o.w = pk2(s[6 * 33], s[7 * 33]);
        *(u32x4*)(WT + (size_t)(orow0 + n) * ldt + k0 + 8 * c) = o; }
    asm volatile("s_waitcnt lgkmcnt(0)" ::: "memory");
}

__device__ __forceinline__ void p0_prologue(const Args& a, unsigned char* lds, int vcu, int NGW) {
    const int tid = tid_now(), lane = tid & 63, wave = __builtin_amdgcn_readfirstlane(tid >> 6), gw = vcu * 8 + wave;
    float* SC = (float*)(lds + 131072);
    for (int i = tid; i < 3 * 1024; i += 512) { const int c = i >> 10, k = i & 1023; const float v = (c == 0) ? inptr(I_CCTX)[k] : inptr(I_C)[(c - 1) * 1024 + k]; SC[i] = silu_f(v); }
    __syncthreads();
    float* scr = (float*)(lds + wave * 16384);
    float* MODP = (float*)(a.ws + WS_MODP);
    constexpr int N_ADA = 2304, N_FOLD = 1024, N_TRL = 10112, N_TR = 2 * N_TRL, NIT = N_ADA + N_FOLD + N_TR;
    for (int it = gw; it < NIT; it += NGW) {
        if (it < N_ADA) {
            const int l = it / 1152, r2 = it % 1152, cb = r2 >> 3, kc = r2 & 7, col = cb * 64 + lane;
            const float* W = inptr(I_WADA) + (size_t)l * 1024 * NMOD + (size_t)(kc * 128) * NMOD + col;
            const float* s0 = SC + kc * 128;
            float a0 = 0.f, a1 = 0.f, a2 = 0.f;
#pragma unroll 32
            for (int k = 0; k < 128; ++k) { const float w = W[(size_t)k * NMOD]; a0 += s0[k] * w; a1 += s0[1024 + k] * w; a2 += s0[2048 + k] * w; }
            float* o = MODP + (size_t)((l * 8 + kc) * 3) * NMOD + col;
            o[0] = a0; o[NMOD] = a1; o[2 * NMOD] = a2;
        } else if (it < N_ADA + N_FOLD) {
            const int r = it - N_ADA, l = r >> 9, r2 = r & 511, kg = r2 >> 4, nb = r2 & 15, k0 = kg * 8, n = nb * 64 + lane;
            const float* pw = inptr(I_CPW) + (size_t)l * 65536 + (size_t)k0 * 256;
            const float* wm = inptr(I_WMO) + (size_t)l * 1048576 + (size_t)512 * 1024 + n;
            float acc[8];
#pragma unroll
            for (int q = 0; q < 8; ++q) acc[q] = 0.f;
#pragma unroll 16
            for (int j = 0; j < 256; ++j) { const float wv = wm[(size_t)j * 1024];
#pragma unroll
                for (int q = 0; q < 8; ++q) acc[q] += pw[q * 256 + j] * wv; }
            bf16_t* WT = (bf16_t*)(a.ws + WS_W + l * WL + WO_MO);
            u32x4 o; o.x = pk2(acc[0], acc[1]); o.y = pk2(acc[2], acc[3]); o.z = pk2(acc[4], acc[5]); o.w = pk2(acc[6], acc[7]);
            *(u32x4*)(WT + (size_t)n * 1024 + 512 + k0) = o;
        } else {
            int r = it - N_ADA - N_FOLD; const int l = r / N_TRL; r %= N_TRL;
            unsigned char* wl = a.ws + WS_W + l * WL;
            if (r < 8448) {
                const int which = r / 1408, q = r % 1408;
                const int ffn = which / 3, kind = which % 3;
                const float* W = inptr((ffn ? I_F2G : I_F1G) + kind) + (size_t)l * 1024 * DFF;
                if (kind < 2) { const int kb = q / 88, nb = q % 88, n0 = nb * 32;
                    tr_item(W, DFF, (bf16_t*)(wl + (ffn ? WO_GU2 : WO_GU1)), 1024, kb * 64, n0, (n0 >> 7) * 256 + (n0 & 127) + kind * 128, scr, lane); }
                else { const int kb = q / 32, nb = q % 32;
                    tr_item(W, 1024, (bf16_t*)(wl + (ffn ? WO_D2 : WO_D1)), DFF, kb * 64, nb * 32, nb * 32, scr, lane); }
            } else if (r < 8448 + 1280) { const int q = r - 8448, kb = q / 80, nb = q % 80;
                tr_item(inptr(I_WMI) + (size_t)l * 1024 * MIXIN, MIXIN, (bf16_t*)(wl + WO_MI), 1024, kb * 64, nb * 32, nb * 32, scr, lane);
            } else { const int q = r - 9728, kbi = q / 32, nb = q % 32, kb = kbi < 8 ? kbi : kbi + 4;
                tr_item(inptr(I_WMO) + (size_t)l * 1048576, 1024, (bf16_t*)(wl + WO_MO), 1024, kb * 64, nb * 32, nb * 32, scr, lane);
            }
        }
    }
}

__device__ __forceinline__ void mod_finalize(const Args& a, int vcu, int G) {
    const int tid = tid_now();
    const float* MODP = (const float*)(a.ws + WS_MODP); float* TAB = (float*)(a.ws + WS_TAB);
    const float* bada = inptr(I_BADA); const float* npost = inptr(I_NPOST); const float* npre = inptr(I_NPRE);
    for (int idx = vcu * 512 + tid; idx < 2 * 27 * 1024; idx += G * 512) {
        const int j = idx & 1023; int t = idx >> 10; const int c = t % 3; t /= 3; const int kind = t % 3; t /= 3; const int i = t % 3, l = t / 3;
        const int mi = kind == 0 ? 3 * i + 2 : (kind == 1 ? 3 * i + 1 : 3 * i);
        float v = bada[(size_t)l * NMOD + mi * 1024 + j];
#pragma unroll
        for (int kc = 0; kc < 8; ++kc) v += MODP[(size_t)((l * 8 + kc) * 3 + c) * NMOD + mi * 1024 + j];
        const float gs = (i == 1) ? 1.0f : 0.5f;
        TAB[idx] = kind == 0 ? gs * v * npost[(l * 3 + i) * 1024 + j] : (kind == 1 ? (1.0f + v) * npre[(l * 3 + i) * 1024 + j] : v);
    }
}

__device__ __forceinline__ void norm_phase(const Args& a, unsigned char* lds, int vcu, int NGW,
                                           bool first, bool has_prev, int lp, int ip, bool has_next, int ln, int in_, bool dry = false) {
    const int tid = tid_now(), lane = tid & 63, wave = __builtin_amdgcn_readfirstlane(tid >> 6), gw = vcu * 8 + wave;
    float* MV = (float*)lds;
    const float* TAB = (const float*)(a.ws + WS_TAB);
    __syncthreads();
    for (int idx = tid * 4; idx < 9216; idx += 2048) {
        const int kind = idx / 3072, rem = idx % 3072;
        const int l = kind == 0 ? lp : ln, i = kind == 0 ? ip : in_;
        f32x4 v = (f32x4){0.f, 0.f, 0.f, 0.f};
        if (kind == 0 ? has_prev : has_next) v = *(const f32x4*)(TAB + (size_t)(((l * 3 + i) * 3 + kind) * 3) * 1024 + rem);
        *(f32x4*)(MV + idx) = v;
    }
    __syncthreads();
    float* X = a.out; float* XO = dry ? (float*)(a.ws + WS_ACT) : a.out;
    const bf16_t* Y0 = (const bf16_t*)(a.ws + WS_Y); const bf16_t* Y1 = Y0 + (size_t)TOK * D;
    bf16_t* H = (bf16_t*)(a.ws + (dry ? WS_CAT : WS_H));
    const float* xp = inptr(I_XP); const float* xsm = inptr(I_XS);
    constexpr int R = 4;
    const int co = 8 * lane;
    for (int r0 = gw; r0 < TOK; r0 += R * NGW) {
        f32x4 x[R][4]; u32x4 ya[R][2], yb[R][2];
#pragma unroll
        for (int rr = 0; rr < R; ++rr) { const int row = r0 + rr * NGW;
            if (row < TOK) {
                const float* xs = first ? (row < CTX_TOK ? xp + (size_t)row * D : xsm + (size_t)(row - CTX_TOK) * D) : X + (size_t)row * D;
#pragma unroll
                for (int j = 0; j < 2; ++j) { x[rr][2 * j] = *(const f32x4*)(xs + co + 512 * j); x[rr][2 * j + 1] = *(const f32x4*)(xs + co + 512 * j + 4); }
                if (has_prev) {
#pragma unroll
                    for (int j = 0; j < 2; ++j) { ya[rr][j] = *(const u32x4*)(Y0 + (size_t)row * D + co + 512 * j); yb[rr][j] = *(const u32x4*)(Y1 + (size_t)row * D + co + 512 * j); }
                }
            } }
#pragma unroll
        for (int rr = 0; rr < R; ++rr) { const int row = r0 + rr * NGW;
            if (row < TOK) {
                const int c = row < CTX_TOK ? 0 : (row < CTX_TOK + SEQ_L ? 1 : 2);
                if (has_prev) {
                    f32x4 y[4]; float s = 0.f;
#pragma unroll
                    for (int j = 0; j < 2; ++j) {
#pragma unroll
                        for (int q = 0; q < 4; ++q) { const unsigned wa = ya[rr][j][q], wb = yb[rr][j][q];
                            const float lo = __builtin_bit_cast(float, wa << 16) + __builtin_bit_cast(float, wb << 16);
                            const float hi = __builtin_bit_cast(float, wa & 0xffff0000u) + __builtin_bit_cast(float, wb & 0xffff0000u);
                            y[2 * j + (q >> 1)][2 * (q & 1)] = lo; y[2 * j + (q >> 1)][2 * (q & 1) + 1] = hi; s += lo * lo + hi * hi; } }
                    const float ry = rsqrtf(wave_sum(s) * (1.0f / D) + EPS);
#pragma unroll
                    for (int j = 0; j < 2; ++j)
#pragma unroll
                        for (int h2 = 0; h2 < 2; ++h2) { const f32x4 gp = *(const f32x4*)(MV + c * 1024 + co + 512 * j + 4 * h2); x[rr][2 * j + h2] = x[rr][2 * j + h2] + gp * y[2 * j + h2] * ry; }
                }
                if (has_prev) {
#pragma unroll
                    for (int j = 0; j < 2; ++j) { *(f32x4*)(XO + (size_t)row * D + co + 512 * j) = x[rr][2 * j]; *(f32x4*)(XO + (size_t)row * D + co + 512 * j + 4) = x[rr][2 * j + 1]; }
                }
                if (has_next) {
                    float s = 0.f;
#pragma unroll
                    for (int q = 0; q < 4; ++q) s += (x[rr][q][0] * x[rr][q][0] + x[rr][q][1] * x[rr][q][1]) + (x[rr][q][2] * x[rr][q][2] + x[rr][q][3] * x[rr][q][3]);
                    const float rx = rsqrtf(wave_sum(s) * (1.0f / D) + EPS);
#pragma unroll
                    for (int j = 0; j < 2; ++j) {
                        const f32x4 a0 = *(const f32x4*)(MV + 3072 + c * 1024 + co + 512 * j), a1 = *(const f32x4*)(MV + 3072 + c * 1024 + co + 512 * j + 4);
                        const f32x4 s0 = *(const f32x4*)(MV + 6144 + c * 1024 + co + 512 * j), s1 = *(const f32x4*)(MV + 6144 + c * 1024 + co + 512 * j + 4);
                        const f32x4 h0 = x[rr][2 * j] * rx * a0 + s0, h1 = x[rr][2 * j + 1] * rx * a1 + s1;
                        u32x4 w; w.x = pg8::cvt_pk_bf16(h0[0], h0[1]); w.y = pg8::cvt_pk_bf16(h0[2], h0[3]); w.z = pg8::cvt_pk_bf16(h1[0], h1[1]); w.w = pg8::cvt_pk_bf16(h1[2], h1[3]);
                        *(u32x4*)(H + (size_t)row * D + co + 512 * j) = w; }
                }
            } }
    }
}

__device__ __forceinline__ void rope_pair(float& x, float xp, float ang, bool second) {
    const float s = __sinf(ang), c = __cosf(ang);
    x = second ? (xp * s + x * c) : (x * c - xp * s);
}
__device__ __forceinline__ float bflo(unsigned w) { return __builtin_bit_cast(float, w << 16); }
__device__ __forceinline__ float bfhi(unsigned w) { return __builtin_bit_cast(float, w & 0xffff0000u); }
__device__ __forceinline__ void mix_prep(const Args& a, unsigned char* lds, int l) {
    const int tid = tid_now(), lane = tid & 63, wave = __builtin_amdgcn_readfirstlane(tid >> 6);
    const bf16_t* PROJ = (const bf16_t*)(a.ws + WS_ACT);
    bf16_t* CAT = (bf16_t*)(a.ws + WS_CAT);
    bf16_t* QD = (bf16_t*)(a.ws + WS_QD); bf16_t* QG = (bf16_t*)(a.ws + WS_QG);
    float* U = (float*)lds;
    float* VB = (float*)(lds + 65536);
    const float qs_d = 0.17677669529663687f * LOG2E, qs_g = 0.125f * LOG2E;
    const float L2T = 13.287712379549449f;
    float invd[4], invg[4], invk[2];
#pragma unroll
    for (int t = 0; t < 4; ++t) { invd[t] = exp2f(-(float)(4 * (lane & 1) + t) * (L2T / 8.0f)); invg[t] = exp2f(-(float)(4 * (lane & 3) + t) * (L2T / 16.0f)); }
#pragma unroll
    for (int t = 0; t < 2; ++t) invk[t] = exp2f(-(float)(2 * (lane & 7) + t) * (L2T / 16.0f));
    for (int tile = blockIdx.x; tile < TOK / 32; tile += gridDim.x) {
        const int row0 = tile * 32; const bool lat = row0 >= CTX_TOK;
        int seq, pos0, seqlen;
        if (!lat) { seq = row0 / SEQ_C; pos0 = row0 % SEQ_C; seqlen = SEQ_C; } else { seq = (row0 - CTX_TOK) / SEQ_L; pos0 = (row0 - CTX_TOK) % SEQ_L; seqlen = SEQ_L; }
        bf16_t* KD = lat ? (bf16_t*)(a.ws + WS_KDL) + (size_t)(seq * S_LAT + 256) * 256 : (bf16_t*)(a.ws + WS_KDC) + (size_t)(seq * SEQ_C) * 256;
        bf16_t* VD = lat ? (bf16_t*)(a.ws + WS_VDL) + (size_t)(seq * S_LAT + 256) * 256 : (bf16_t*)(a.ws + WS_VDC) + (size_t)(seq * SEQ_C) * 256;
        bf16_t* KG = lat ? (bf16_t*)(a.ws + WS_KGL) + (size_t)(seq * S_LAT + 256) * 128 : (bf16_t*)(a.ws + WS_KGC) + (size_t)(seq * SEQ_C) * 128;
        bf16_t* VG = lat ? (bf16_t*)(a.ws + WS_VGL) + (size_t)(seq * S_LAT + 256) * 128 : (bf16_t*)(a.ws + WS_VGC) + (size_t)(seq * SEQ_C) * 128;
#pragma unroll 1
        for (int hh = 0; hh < 2; ++hh) {
            const int row_b = row0 + wave * 4 + hh * 2, pos_b = pos0 + wave * 4 + hh * 2;
            u32x2 dq[2], dk[2], dv[2], gqp[2][4], ab[2], ac[4], ah[4]; unsigned gkp[2][4], gvp[2][4];
#pragma unroll
            for (int rr = 0; rr < 2; ++rr) { const bf16_t* pr = PROJ + (size_t)(row_b + rr) * MIXIN;
                dq[rr] = *(const u32x2*)(pr + 768 + 4 * lane); dk[rr] = *(const u32x2*)(pr + 1024 + 4 * lane); dv[rr] = *(const u32x2*)(pr + 1280 + 4 * lane);
                ab[rr] = *(const u32x2*)(pr + 4 * lane); }
#pragma unroll
            for (int t = 0; t < 4; ++t) { const int tp = pos_b - 1 + t; const bool valid = tp >= 0 && tp < seqlen; const bf16_t* pr = PROJ + (size_t)(row_b - 1 + t) * MIXIN;
                ac[t] = (u32x2){0u, 0u}; ah[t] = (u32x2){0u, 0u};
                if (valid) { ac[t] = *(const u32x2*)(pr + 256 + 4 * lane); ah[t] = *(const u32x2*)(pr + 512 + 4 * lane); } }
#pragma unroll
            for (int rr = 0; rr < 2; ++rr) { const int row = row_b + rr, pos = pos_b + rr;
                float q[4] = {bflo(dq[rr].x), bfhi(dq[rr].x), bflo(dq[rr].y), bfhi(dq[rr].y)};
                float k[4] = {bflo(dk[rr].x), bfhi(dk[rr].x), bflo(dk[rr].y), bfhi(dk[rr].y)};
                if (lat) {
                    const float pax = (float)((lane & 4) ? (pos & 63) : (pos >> 6)); const bool second = (lane & 2) != 0;
#pragma unroll
                    for (int t = 0; t < 4; ++t) { const float ang = pax * invd[t]; const float sn = __sinf(ang), cs = __cosf(ang);
                        const float qp = __shfl_xor(q[t], 2), kp = __shfl_xor(k[t], 2);
                        q[t] = second ? (qp * sn + q[t] * cs) : (q[t] * cs - qp * sn); k[t] = second ? (kp * sn + k[t] * cs) : (k[t] * cs - kp * sn); }
                } else {
                    float* odk = a.out + 8388608 + ((size_t)(seq * 2 + l) * 256 + pos) * 256 + 4 * lane;
                    float* odv = a.out + 10485760 + ((size_t)(seq * 2 + l) * 256 + pos) * 256 + 4 * lane;
                    *(f32x4*)odk = (f32x4){k[0], k[1], k[2], k[3]};
                    *(f32x4*)odv = (f32x4){bflo(dv[rr].x), bfhi(dv[rr].x), bflo(dv[rr].y), bfhi(dv[rr].y)};
                }
                u32x2 w; w.x = pg8::cvt_pk_bf16(q[0] * qs_d, q[1] * qs_d); w.y = pg8::cvt_pk_bf16(q[2] * qs_d, q[3] * qs_d);
                *(u32x2*)(QD + (size_t)row * 256 + 4 * lane) = w;
                w.x = pg8::cvt_pk_bf16(k[0], k[1]); w.y = pg8::cvt_pk_bf16(k[2], k[3]);
                *(u32x2*)(KD + (size_t)pos * 256 + 4 * lane) = w;
                *(u32x2*)(VD + (size_t)pos * 256 + 4 * lane) = dv[rr];
            }
            asm volatile("" ::: "memory");
            const bf16_t* PART = (const bf16_t*)(a.ws + WS_Y);
#pragma unroll
            for (int rr = 0; rr < 2; ++rr)
#pragma unroll
                for (int ks = 0; ks < 4; ++ks) { const bf16_t* pp = PART + ((size_t)ks * TOK + row_b + rr) * 512;
                    gqp[rr][ks] = *(const u32x2*)(pp + 4 * lane); gkp[rr][ks] = *(const unsigned*)(pp + 256 + 2 * lane); gvp[rr][ks] = *(const unsigned*)(pp + 384 + 2 * lane); }
            const f32x4 qnv = *(const f32x4*)(inptr(I_QNORM) + l * 64 + 4 * (lane & 15));
#pragma unroll
            for (int rr = 0; rr < 2; ++rr) { const int row = row_b + rr, pos = pos_b + rr;
                float q[4] = {0.f, 0.f, 0.f, 0.f};
#pragma unroll
                for (int ks = 0; ks < 4; ++ks) { q[0] += bflo(gqp[rr][ks].x); q[1] += bfhi(gqp[rr][ks].x); q[2] += bflo(gqp[rr][ks].y); q[3] += bfhi(gqp[rr][ks].y); }
                float ss = (q[0] * q[0] + q[1] * q[1]) + (q[2] * q[2] + q[3] * q[3]);
                ss += __shfl_xor(ss, 1); ss += __shfl_xor(ss, 2); ss += __shfl_xor(ss, 4); ss += __shfl_xor(ss, 8);
                const float rn = rsqrtf(ss * (1.0f / 64.0f) + EPS);
#pragma unroll
                for (int t = 0; t < 4; ++t) q[t] = q[t] * rn * qnv[t];
                if (lat) {
                    const float pax = (float)((lane & 8) ? (pos & 63) : (pos >> 6)); const bool second = (lane & 4) != 0;
#pragma unroll
                    for (int t = 0; t < 4; ++t) { const float ang = pax * invg[t]; const float sn = __sinf(ang), cs = __cosf(ang);
                        const float qp = __shfl_xor(q[t], 4);
                        q[t] = second ? (qp * sn + q[t] * cs) : (q[t] * cs - qp * sn); }
                }
                u32x2 w; w.x = pg8::cvt_pk_bf16(q[0] * qs_g, q[1] * qs_g); w.y = pg8::cvt_pk_bf16(q[2] * qs_g, q[3] * qs_g);
                *(u32x2*)(QG + (size_t)row * 256 + 4 * lane) = w;
            }
            const float kn0 = inptr(I_KNORM)[l * 64 + 2 * (lane & 31)], kn1 = inptr(I_KNORM)[l * 64 + 2 * (lane & 31) + 1];
#pragma unroll
            for (int rr = 0; rr < 2; ++rr) { const int pos = pos_b + rr;
                float k0 = 0.f, k1 = 0.f, v0 = 0.f, v1 = 0.f;
#pragma unroll
                for (int ks = 0; ks < 4; ++ks) { k0 += bflo(gkp[rr][ks]); k1 += bfhi(gkp[rr][ks]); v0 += bflo(gvp[rr][ks]); v1 += bfhi(gvp[rr][ks]); }
                const unsigned vpk = pg8::cvt_pk_bf16(v0, v1);
                float ss = k0 * k0 + k1 * k1;
                ss += __shfl_xor(ss, 1); ss += __shfl_xor(ss, 2); ss += __shfl_xor(ss, 4); ss += __shfl_xor(ss, 8); ss += __shfl_xor(ss, 16);
                const float rn = rsqrtf(ss * (1.0f / 64.0f) + EPS);
                k0 = k0 * rn * kn0; k1 = k1 * rn * kn1;
                if (lat) {
                    const float pax = (float)((lane & 16) ? (pos & 63) : (pos >> 6)); const bool second = (lane & 8) != 0;
                    const float a0 = pax * invk[0], a1 = pax * invk[1];
                    const float s0 = __sinf(a0), c0 = __cosf(a0), s1 = __sinf(a1), c1 = __cosf(a1);
                    const float p0 = __shfl_xor(k0, 8), p1 = __shfl_xor(k1, 8);
                    k0 = second ? (p0 * s0 + k0 * c0) : (k0 * c0 - p0 * s0); k1 = second ? (p1 * s1 + k1 * c1) : (k1 * c1 - p1 * s1);
                } else {
                    float* ogk = a.out + 12582912 + ((size_t)(seq * 2 + l) * 256 + pos) * 128 + 2 * lane;
                    float* ogv = a.out + 13631488 + ((size_t)(seq * 2 + l) * 256 + pos) * 128 + 2 * lane;
                    typedef float f32x2 __attribute__((ext_vector_type(2)));
                    *(f32x2*)ogk = (f32x2){k0, k1}; *(f32x2*)ogv = (f32x2){bflo(vpk), bfhi(vpk)};
                }
                *(unsigned*)(KG + (size_t)pos * 128 + 2 * lane) = pg8::cvt_pk_bf16(k0, k1);
                *(unsigned*)(VG + (size_t)pos * 128 + 2 * lane) = vpk;
            }
            {
                f32x4 scw[3];
#pragma unroll
                for (int k = 0; k < 3; ++k) scw[k] = *(const f32x4*)(inptr(I_SCW) + (l * 3 + k) * 256 + 4 * lane);
                float pr6[4][4];
#pragma unroll
                for (int t = 0; t < 4; ++t) { pr6[t][0] = bflo(ac[t].x) * bflo(ah[t].x); pr6[t][1] = bfhi(ac[t].x) * bfhi(ah[t].x); pr6[t][2] = bflo(ac[t].y) * bflo(ah[t].y); pr6[t][3] = bfhi(ac[t].y) * bfhi(ah[t].y); }
#pragma unroll
                for (int rr = 0; rr < 2; ++rr) {
                    float o[4]; const float b4[4] = {bflo(ab[rr].x), bfhi(ab[rr].x), bflo(ab[rr].y), bfhi(ab[rr].y)};
#pragma unroll
                    for (int e = 0; e < 4; ++e) o[e] = b4[e] * (scw[0][e] * pr6[rr][e] + scw[1][e] * pr6[rr + 1][e] + scw[2][e] * pr6[rr + 2][e]);
                    u32x2 w; w.x = pg8::cvt_pk_bf16(o[0], o[1]); w.y = pg8::cvt_pk_bf16(o[2], o[3]);
                    *(u32x2*)(CAT + (size_t)(row_b + rr) * D + 4 * lane) = w;
                }
            }
        }
        if (wave < 2) {
            const int id = tile * 2 + wave, b = id >> 8, p = id & 255;
            const size_t src = ((size_t)(b * 2 + l) * 256 + p);
            typedef float f32x2 __attribute__((ext_vector_type(2)));
            const f32x4 ck = *(const f32x4*)(inptr(I_CDK) + src * 256 + 4 * lane), cv = *(const f32x4*)(inptr(I_CDV) + src * 256 + 4 * lane);
            const f32x2 gkk = *(const f32x2*)(inptr(I_CGK) + src * 128 + 2 * lane), gvv = *(const f32x2*)(inptr(I_CGV) + src * 128 + 2 * lane);
            u32x2 w; w.x = pg8::cvt_pk_bf16(ck[0], ck[1]); w.y = pg8::cvt_pk_bf16(ck[2], ck[3]);
            *(u32x2*)((bf16_t*)(a.ws + WS_KDL) + (size_t)(b * S_LAT + p) * 256 + 4 * lane) = w;
            w.x = pg8::cvt_pk_bf16(cv[0], cv[1]); w.y = pg8::cvt_pk_bf16(cv[2], cv[3]);
            *(u32x2*)((bf16_t*)(a.ws + WS_VDL) + (size_t)(b * S_LAT + p) * 256 + 4 * lane) = w;
            *(unsigned*)((bf16_t*)(a.ws + WS_KGL) + (size_t)(b * S_LAT + p) * 128 + 2 * lane) = pg8::cvt_pk_bf16(gkk[0], gkk[1]);
            *(unsigned*)((bf16_t*)(a.ws + WS_VGL) + (size_t)(b * S_LAT + p) * 128 + 2 * lane) = pg8::cvt_pk_bf16(gvv[0], gvv[1]);
        }
        __syncthreads();
        {
            const int cp = tid & 127, rg = tid >> 7;
            unsigned ca[16], cgv[16];
#pragma unroll
            for (int i = 0; i < 16; ++i) { const int r = rg + 4 * i, tp = pos0 - 15 + r; ca[i] = 0u; cgv[i] = 0u;
                if (r < 62 && tp >= 0 && tp < seqlen) { const bf16_t* p2 = PROJ + (size_t)(row0 - 15 + r) * MIXIN; ca[i] = *(const unsigned*)(p2 + 1536 + 2 * cp); cgv[i] = *(const unsigned*)(p2 + 1792 + 2 * cp); } }
#pragma unroll
            for (int i = 0; i < 16; ++i) { const int r = rg + 4 * i;
                if (r < 62) { typedef float f32x2 __attribute__((ext_vector_type(2)));
                    const float u0 = bflo(ca[i]) * __builtin_amdgcn_rcpf(1.0f + __builtin_amdgcn_exp2f(-LOG2E * bflo(cgv[i]))), u1 = bfhi(ca[i]) * __builtin_amdgcn_rcpf(1.0f + __builtin_amdgcn_exp2f(-LOG2E * bfhi(cgv[i])));
                    *(f32x2*)(U + r * 256 + 2 * cp) = (f32x2){u0, u1}; } }
        }
        __syncthreads();
        {
            const int c = tid & 255, half = tid >> 8;
            float w[31], acc[16];
#pragma unroll
            for (int k = 0; k < 31; ++k) w[k] = inptr(I_CDWW)[(l * 31 + k) * 256 + c];
            const float bias = inptr(I_CDWB)[l * 256 + c];
#pragma unroll
            for (int o = 0; o < 16; ++o) acc[o] = bias;
#pragma unroll
            for (int i = 0; i < 46; ++i) { const float u = U[(16 * half + i) * 256 + c];
#pragma unroll
                for (int o = 0; o < 16; ++o) { const int k = i - o; if (k >= 0 && k < 31) acc[o] += w[k] * u; } }
#pragma unroll
            for (int o = 0; o < 16; ++o) VB[(16 * half + o) * 256 + c] = acc[o];
        }
        __syncthreads();
        const f32x4 lng = *(const f32x4*)(inptr(I_CLNG) + l * 256 + 4 * lane), lnb = *(const f32x4*)(inptr(I_CLNB) + l * 256 + 4 * lane);
#pragma unroll
        for (int rr = 0; rr < 4; ++rr) {
            const int rl = wave * 4 + rr, row = row0 + rl;
            f32x4 v = *(const f32x4*)(VB + rl * 256 + 4 * lane);
            const float mu = wave_sum((v[0] + v[1]) + (v[2] + v[3])) * (1.0f / 256.0f);
            v = v - mu;
            const float rstd = rsqrtf(wave_sum((v[0] * v[0] + v[1] * v[1]) + (v[2] * v[2] + v[3] * v[3])) * (1.0f / 256.0f) + EPS);
            const f32x4 y = v * rstd * lng + lnb;
            u32x2 w; w.x = pg8::cvt_pk_bf16(silu_f(y[0]), silu_f(y[1])); w.y = pg8::cvt_pk_bf16(silu_f(y[2]), silu_f(y[3]));
            *(u32x2*)(CAT + (size_t)row * D + 512 + 4 * lane) = w;
        }
        __syncthreads();
    }
}

constexpr int AT_KB = 64 * 144;
constexpr int AT_K0 = 0, AT_V0 = 2 * AT_KB, AT_XCH = 40960;
template <int DK>
__device__ __forceinline__ void attn_unit(unsigned char* lds, const Args& a, int l, bool is_diff, int hidx, int qrow0, const bf16_t* Kp, const bf16_t* Vp, int ldkv, int S) {
    const int tid = tid_now(), lane = tid & 63, wave = __builtin_amdgcn_readfirstlane(tid >> 6), sub = wave >> 2, wq = wave & 3, r32 = lane & 31, hi = lane >> 5;
    const int kcol = hidx * 64;
    const int kcsub = is_diff ? sub * 32 : 0;
    const bf16_t* Qp = is_diff ? (const bf16_t*)(a.ws + WS_QD) + hidx * 64 + sub * 32 : (const bf16_t*)(a.ws + WS_QG) + (2 * hidx + sub) * 64;
    const int qrow = qrow0 + wq * 32 + r32;
    bf16x8 qf[DK / 16];
#pragma unroll
    for (int d0 = 0; d0 < DK / 16; ++d0) qf[d0] = *(const bf16x8*)(Qp + (size_t)qrow * 256 + d0 * 16 + hi * 8);
    const int sr = tid & 63, sch = tid >> 6;
    const bf16_t* kg = Kp + (size_t)sr * ldkv + kcol + sch * 8; const bf16_t* vg = Vp + (size_t)sr * ldkv + kcol + sch * 8;
    const int o16 = sr & 15; const int vcol = 16 * (sr >> 4) + 8 * ((o16 >> 2) & 1) + (o16 & 3) + 4 * (o16 >> 3);
    u32x4 kreg = *(const u32x4*)kg, vreg = *(const u32x4*)vg;
    const int NT = S / 64;
    float m_run = 0.f, l_run = 0.f;
    f32x16 negm;
#pragma unroll
    for (int r = 0; r < 16; ++r) negm[r] = 0.f;
    f32x16 o0, o1;
#pragma unroll
    for (int r = 0; r < 16; ++r) { o0[r] = 0.f; o1[r] = 0.f; }
    for (int t = 0; t < NT; ++t) {
        unsigned char* kb = lds + AT_K0 + (t & 1) * AT_KB; unsigned char* vb = lds + AT_V0 + (t & 1) * AT_KB;
        *(u32x4*)(kb + sr * 144 + sch * 16) = kreg;
        {
            bf16_t* vt = (bf16_t*)vb + (sch * 8) * 72 + vcol;
            vt[0 * 72] = (bf16_t)(vreg.x & 0xffffu); vt[1 * 72] = (bf16_t)(vreg.x >> 16); vt[2 * 72] = (bf16_t)(vreg.y & 0xffffu); vt[3 * 72] = (bf16_t)(vreg.y >> 16);
            vt[4 * 72] = (bf16_t)(vreg.z & 0xffffu); vt[5 * 72] = (bf16_t)(vreg.z >> 16); vt[6 * 72] = (bf16_t)(vreg.w & 0xffffu); vt[7 * 72] = (bf16_t)(vreg.w >> 16);
        }
        __syncthreads();
        if (t + 1 < NT) { kreg = *(const u32x4*)(kg + (size_t)(t + 1) * 64 * ldkv); vreg = *(const u32x4*)(vg + (size_t)(t + 1) * 64 * ldkv); }
        f32x16 p0, p1;
#pragma unroll
        for (int d0 = 0; d0 < DK / 16; ++d0) {
            const bf16x8 k0 = *(const bf16x8*)(kb + r32 * 144 + (kcsub + 16 * d0 + 8 * hi) * 2);
            const bf16x8 k1 = *(const bf16x8*)(kb + (32 + r32) * 144 + (kcsub + 16 * d0 + 8 * hi) * 2);
            if (d0 == 0) { p0 = __builtin_amdgcn_mfma_f32_32x32x16_bf16(k0, qf[0], negm, 0, 0, 0); p1 = __builtin_amdgcn_mfma_f32_32x32x16_bf16(k1, qf[0], negm, 0, 0, 0); }
            else { p0 = __builtin_amdgcn_mfma_f32_32x32x16_bf16(k0, qf[d0], p0, 0, 0, 0); p1 = __builtin_amdgcn_mfma_f32_32x32x16_bf16(k1, qf[d0], p1, 0, 0, 0); }
        }
        float mxa = fmaxf(fmaxf(p0[0], p0[1]), p1[0]), mxb = fmaxf(fmaxf(p0[2], p0[3]), p1[1]);
        mxa = fmaxf(fmaxf(mxa, p1[2]), p1[3]);
#pragma unroll
        for (int r = 4; r < 16; r += 4) { mxa = fmaxf(fmaxf(mxa, p0[r]), p0[r + 1]); mxb = fmaxf(fmaxf(mxb, p0[r + 2]), p0[r + 3]); mxa = fmaxf(fmaxf(mxa, p1[r]), p1[r + 1]); mxb = fmaxf(fmaxf(mxb, p1[r + 2]), p1[r + 3]); }
        float mx = fmaxf(mxa, mxb);
        if (__any(mx > 6.0f)) {
            mx = fmaxf(mx, __shfl_xor(mx, 32));
            const float dl = fmaxf(mx, 0.f); m_run += dl;
            const float alpha = __builtin_amdgcn_exp2f(-dl); l_run *= alpha;
#pragma unroll
            for (int r = 0; r < 16; ++r) { p0[r] -= dl; p1[r] -= dl; o0[r] *= alpha; o1[r] *= alpha; negm[r] = -m_run; }
        }
#pragma unroll
        for (int r = 0; r < 16; ++r) { p0[r] = __builtin_amdgcn_exp2f(p0[r]); p1[r] = __builtin_amdgcn_exp2f(p1[r]); }
        {
            typedef float f32x2 __attribute__((ext_vector_type(2)));
            f32x2 s2 = (f32x2){p0[0], p0[1]} + (f32x2){p1[0], p1[1]};
#pragma unroll
            for (int r = 2; r < 16; r += 2) { s2 += (f32x2){p0[r], p0[r + 1]}; s2 += (f32x2){p1[r], p1[r + 1]}; }
            l_run += s2[0] + s2[1];
        }
        bf16x8 pk[4];
#pragma unroll
        for (int ks = 0; ks < 4; ++ks) {
            u32x4 w;
            if (ks < 2) { w.x = pg8::cvt_pk_bf16(p0[8 * ks + 0], p0[8 * ks + 1]); w.y = pg8::cvt_pk_bf16(p0[8 * ks + 2], p0[8 * ks + 3]); w.z = pg8::cvt_pk_bf16(p0[8 * ks + 4], p0[8 * ks + 5]); w.w = pg8::cvt_pk_bf16(p0[8 * ks + 6], p0[8 * ks + 7]); }
            else { const int b = 8 * (ks - 2); w.x = pg8::cvt_pk_bf16(p1[b + 0], p1[b + 1]); w.y = pg8::cvt_pk_bf16(p1[b + 2], p1[b + 3]); w.z = pg8::cvt_pk_bf16(p1[b + 4], p1[b + 5]); w.w = pg8::cvt_pk_bf16(p1[b + 6], p1[b + 7]); }
            pk[ks] = __builtin_bit_cast(bf16x8, w);
        }
#pragma unroll
        for (int ks = 0; ks < 4; ++ks) {
            const bf16x8 v0 = *(const bf16x8*)(vb + r32 * 144 + (16 * ks + 8 * hi) * 2);
            const bf16x8 v1 = *(const bf16x8*)(vb + (32 + r32) * 144 + (16 * ks + 8 * hi) * 2);
            o0 = __builtin_amdgcn_mfma_f32_32x32x16_bf16(v0, pk[ks], o0, 0, 0, 0);
            o1 = __builtin_amdgcn_mfma_f32_32x32x16_bf16(v1, pk[ks], o1, 0, 0, 0);
        }
    }
    const float lt = l_run + __shfl_xor(l_run, 32); const float inv = 1.0f / lt;
#pragma unroll
    for (int r = 0; r < 16; ++r) { o0[r] *= inv; o1[r] *= inv; }
    bf16_t* CAT = (bf16_t*)(a.ws + WS_CAT);
    if (is_diff) {
        float* XCH = (float*)(lds + AT_XCH);
        if (sub == 1) {
#pragma unroll
            for (int r = 0; r < 16; ++r) { XCH[(wq * 32 + r) * 64 + lane] = o0[r]; XCH[(wq * 32 + 16 + r) * 64 + lane] = o1[r]; }
        }
        __syncthreads();
        if (sub == 0) {
            float d1 = (lane < 32) ? inptr(I_LQ1)[l * 32 + lane] * inptr(I_LK1)[l * 32 + lane] : 0.f;
            float d2 = (lane < 32) ? inptr(I_LQ2)[l * 32 + lane] * inptr(I_LK2)[l * 32 + lane] : 0.f;
            const float lam_init = (l == 0) ? 0.2f : 0.35550907f;
            const float lam = __expf(wave_sum(d1)) - __expf(wave_sum(d2)) + lam_init;
            float ss = 0.f;
#pragma unroll
            for (int r = 0; r < 16; ++r) { o0[r] -= lam * XCH[(wq * 32 + r) * 64 + lane]; o1[r] -= lam * XCH[(wq * 32 + 16 + r) * 64 + lane]; ss += o0[r] * o0[r] + o1[r] * o1[r]; }
            ss += __shfl_xor(ss, 32);
            const float rs = rsqrtf(ss * (1.0f / 64.0f) + EPS) * (1.0f - lam_init);
            bf16_t* op = CAT + (size_t)qrow * D + 256 + hidx * 64;
#pragma unroll
            for (int g = 0; g < 4; ++g) {
                const int d = 8 * g + 4 * hi; const float* sl = inptr(I_SUBLN) + l * 64;
                u32x2 w0, w1;
                w0.x = pk2(o0[4 * g + 0] * rs * sl[d + 0], o0[4 * g + 1] * rs * sl[d + 1]); w0.y = pk2(o0[4 * g + 2] * rs * sl[d + 2], o0[4 * g + 3] * rs * sl[d + 3]);
                w1.x = pk2(o1[4 * g + 0] * rs * sl[32 + d + 0], o1[4 * g + 1] * rs * sl[32 + d + 1]); w1.y = pk2(o1[4 * g + 2] * rs * sl[32 + d + 2], o1[4 * g + 3] * rs * sl[32 + d + 3]);
                *(u32x2*)(op + d) = w0; *(u32x2*)(op + 32 + d) = w1;
            }
        }
    } else {
        bf16_t* op = CAT + (size_t)qrow * D + 768 + (2 * hidx + sub) * 64;
#pragma unroll
        for (int g = 0; g < 4; ++g) {
            const int d = 8 * g + 4 * hi;
            u32x2 w0, w1;
            w0.x = pk2(o0[4 * g + 0], o0[4 * g + 1]); w0.y = pk2(o0[4 * g + 2], o0[4 * g + 3]);
            w1.x = pk2(o1[4 * g + 0], o1[4 * g + 1]); w1.y = pk2(o1[4 * g + 2], o1[4 * g + 3]);
            *(u32x2*)(op + d) = w0; *(u32x2*)(op + 32 + d) = w1;
        }
    }
    __syncthreads();
}

__device__ __forceinline__ void attn_phase(const Args& a, unsigned char* lds, int l, int rep) {
    unsigned* ctr = (unsigned*)(a.ws + WS_CTL) + 64 * (1 + l + 2 * rep);
    unsigned* slot = (unsigned*)(lds + 131072);
    for (;;) {
        __syncthreads();
        if (threadIdx.x == 0) *slot = atomicAdd(ctr, 1u);
        __syncthreads();
        const int u = (int)*slot;
        if (u >= 384) break;
        bool is_diff, lat; int seq, qb, hidx;
        if (u < 64) { lat = true; is_diff = false; seq = u / 32; const int rem = u % 32; qb = rem >> 1; hidx = rem & 1; }
        else if (u < 192) { const int v = u - 64; lat = true; is_diff = true; seq = v / 64; const int rem = v % 64; qb = rem >> 2; hidx = rem & 3; }
        else if (u < 256) { const int v = u - 192; lat = false; is_diff = false; seq = v >> 2; const int rem = v & 3; qb = rem >> 1; hidx = rem & 1; }
        else { const int v = u - 256; lat = false; is_diff = true; seq = v >> 3; const int rem = v & 7; qb = rem >> 2; hidx = rem & 3; }
        const int qrow0 = lat ? CTX_TOK + seq * SEQ_L + qb * 128 : seq * SEQ_C + qb * 128;
        const int S = lat ? S_LAT : SEQ_C;
        if (is_diff) {
            const bf16_t* Kp = lat ? (const bf16_t*)(a.ws + WS_KDL) + (size_t)seq * S_LAT * 256 : (const bf16_t*)(a.ws + WS_KDC) + (size_t)seq * SEQ_C * 256;
            const bf16_t* Vp = lat ? (const bf16_t*)(a.ws + WS_VDL) + (size_t)seq * S_LAT * 256 : (const bf16_t*)(a.ws + WS_VDC) + (size_t)seq * SEQ_C * 256;
            attn_unit<32>(lds, a, l, true, hidx, qrow0, Kp, Vp, 256, S);
        } else {
            const bf16_t* Kp = lat ? (const bf16_t*)(a.ws + WS_KGL) + (size_t)seq * S_LAT * 128 : (const bf16_t*)(a.ws + WS_KGC) + (size_t)seq * SEQ_C * 128;
            const bf16_t* Vp = lat ? (const bf16_t*)(a.ws + WS_VGL) + (size_t)seq * S_LAT * 128 : (const bf16_t*)(a.ws + WS_VGC) + (size_t)seq * SEQ_C * 128;
            attn_unit<64>(lds, a, l, false, hidx, qrow0, Kp, Vp, 128, S);
        }
    }
}

#define XB_TMO      128
#define XB_XCNT(j)  (256  + 64 * (j))
#define XB_XSUB(j)  (1280 + 64 * (j))
#define XB_XGEN(j)  (2304 + 64 * (j))
#define XB_TOP      3328
#define XB_TOPGEN   3392
#define XCD_BAR_WORDS 3456
#define XB_SPIN_CAP (1u << 18)
__device__ __forceinline__ unsigned xb_ld(unsigned* p)              { return __hip_atomic_load(p, __ATOMIC_RELAXED, __HIP_MEMORY_SCOPE_AGENT); }
__device__ __forceinline__ unsigned xb_add(unsigned* p, unsigned v) { return __hip_atomic_fetch_add(p, v, __ATOMIC_RELAXED, __HIP_MEMORY_SCOPE_AGENT); }
__device__ __forceinline__ unsigned xb_xcc_id() { return (unsigned)__builtin_amdgcn_s_getreg((3 << 11) | 20) & 0xFu; }
#define XB_SPIN(cond, bar) do { unsigned _sp = 0; while (cond) { __builtin_amdgcn_s_sleep(1); \
    if ((++_sp & 255u) == 0u) { if (xb_ld(&(bar)[XB_TMO])) break; if (_sp > XB_SPIN_CAP) { atomicAdd(&(bar)[XB_TMO], 1u); break; } } } } while (0)
struct XcdBarrier { unsigned* bar; unsigned x; volatile LAS unsigned* st; };
__device__ __forceinline__ XcdBarrier xcd_barrier_post(unsigned* bar, volatile LAS unsigned* st) {
    XcdBarrier b; b.bar = bar; b.x = xb_xcc_id(); b.st = st;
    if (threadIdx.x == 0) (void)xb_add(&bar[XB_XCNT(b.x)], 1u);
    return b;
}
__device__ __forceinline__ void xcd_barrier_complete(unsigned* bar, unsigned x, unsigned& nloc, unsigned& nx) {
    const unsigned G = gridDim.x * gridDim.y * gridDim.z;
    unsigned sum, cnt, mine, sp = 0u;
    for (;;) {
        sum = 0u; cnt = 0u; mine = 0u;
#pragma unroll 1
        for (unsigned j = 0; j < 16; ++j) { const unsigned c = xb_ld(&bar[XB_XCNT(j)]); sum += c; cnt += (c > 0u) ? 1u : 0u; mine = (j == x) ? c : mine; }
        if (sum == G) break;
        __builtin_amdgcn_s_sleep(1);
        if ((++sp & 255u) == 0u) { if (xb_ld(&bar[XB_TMO])) break; if (sp > XB_SPIN_CAP) { atomicAdd(&bar[XB_TMO], 1u); break; } }
    }
    nloc = mine > 0u ? mine : 1u; nx = cnt > 0u ? cnt : 1u;
}
__device__ __forceinline__ void xcd_barrier(const XcdBarrier& b) {
    asm volatile("s_waitcnt vmcnt(0)" ::: "memory");
    __syncthreads();
    if (threadIdx.x == 0) {
        unsigned* bar = b.bar;
        __builtin_amdgcn_s_waitcnt(0);
        unsigned nloc = b.st[0], nx = b.st[1];
        if (nloc == 0u) { xcd_barrier_complete(bar, b.x, nloc, nx); b.st[0] = nloc; b.st[1] = nx; }
        const unsigned old = xb_add(&bar[XB_XSUB(b.x)], 1u);
        const unsigned gen = old / nloc;
        if (old + 1u == (gen + 1u) * nloc) {
            __builtin_amdgcn_fence(__ATOMIC_RELEASE, "agent");
            asm volatile("s_waitcnt vmcnt(0)" ::: "memory");
            const unsigned og = xb_add(&bar[XB_TOP], 1u);
            const unsigned tg = og / nx;
            if (og + 1u == (tg + 1u) * nx) xb_add(&bar[XB_TOPGEN], 1u);
            else XB_SPIN(xb_ld(&bar[XB_TOPGEN]) == tg, bar);
            __builtin_amdgcn_fence(__ATOMIC_ACQUIRE, "agent");
            xb_add(&bar[XB_XGEN(b.x)], 1u);
            asm volatile("s_waitcnt vmcnt(0)" ::: "memory");
        } else {
            XB_SPIN(xb_ld(&bar[XB_XGEN(b.x)]) == gen, bar);
            __builtin_amdgcn_fence(__ATOMIC_ACQUIRE, "agent");
            asm volatile("s_waitcnt vmcnt(0)" ::: "memory");
        }
    }
    __syncthreads();
}

__global__ void __launch_bounds__(512, 2) fwd_kernel(Args a) {
    extern __shared__ __attribute__((aligned(16))) unsigned char lds[];
    cg::grid_group grid = cg::this_grid();
    const int G = gridDim.x, bx = blockIdx.x;
    const int vcu = (G % 8 == 0) ? (bx % 8) * (G / 8) + bx / 8 : bx;
    const int NGW = G * 8;
    LAS unsigned char* lds3 = (LAS unsigned char*)lds;
    int ph = 0;
    if (threadIdx.x < 16) ((LAS unsigned*)(lds3 + 131072 + 12288))[threadIdx.x] = 0u;
    __syncthreads();
    XcdBarrier bar = xcd_barrier_post((unsigned*)(a.ws + WS_CTL) + 1024, (volatile LAS unsigned*)(lds3 + 131072 + 12288));
    if (a.ph_hi == -12345) grid.sync();
#define RUN(k) (a.ph_lo <= (k) && (k) < a.ph_hi)
#define SEAM() do { if (a.ph_lo <= ph && ph + 1 < a.ph_hi) { for (int rp_ = 0; rp_ < NREP(1); ++rp_) xcd_barrier(bar); } ++ph; } while (0)
#define REP(k) _Pragma("unroll 1") for (int rp_ = 0; rp_ < NREP(k); ++rp_)

    if (RUN(ph)) { REP(2) p0_prologue(a, lds, vcu, NGW); }
    SEAM();
    if (RUN(ph)) mod_finalize(a, vcu, G);
    SEAM();
    for (int l = 0; l < 2; ++l) {
        unsigned char* wl = a.ws + WS_W + (size_t)l * WL;
        if (l == 0) { if (RUN(ph)) norm_phase(a, lds, vcu, NGW, true, false, 0, 0, true, 0, 0); SEAM(); }
        if (RUN(ph)) { pg8::Gemm g{(const bf16_t*)(a.ws + WS_H), (const bf16_t*)(wl + WO_GU1), D}; pg8::StaticOrder S; S.init(TOK, NGU, 1, G, bx, D);
            pg8::EpiSwiGLU E{(bf16_t*)(a.ws + WS_ACT)}; REP(5) pg8::gemm_phase(lds3, g, S, E); }
        SEAM();
        if (RUN(ph)) { pg8::Gemm g{(const bf16_t*)(a.ws + WS_ACT), (const bf16_t*)(wl + WO_D1), DFF}; pg8::StaticOrder S; S.init(TOK, D, 2, G, bx, DFF / 2);
            pg8::EpiBf16 E{(bf16_t*)(a.ws + WS_Y), D, (size_t)TOK * D}; REP(7) pg8::gemm_phase(lds3, g, S, E); }
        SEAM();
        if (RUN(ph)) { if (PROBE == 6) { for (int rp_ = 0; rp_ < 2; ++rp_) norm_phase(a, lds, vcu, NGW, false, true, l, 0, true, l, 1, true); } norm_phase(a, lds, vcu, NGW, l == 0, true, l, 0, true, l, 1); }
        SEAM();
        if (RUN(ph)) { pg8::Gemm g{(const bf16_t*)(a.ws + WS_H), (const bf16_t*)(wl + WO_MI), D}; pg8::MixInOrder S; S.init(G, bx);
            pg8::EpiMixIn E{(bf16_t*)(a.ws + WS_ACT), (bf16_t*)(a.ws + WS_Y)}; REP(8) pg8::gemm_phase(lds3, g, S, E); }
        SEAM();
        if (RUN(ph)) { REP(4) mix_prep(a, lds, l); }
        SEAM();
        if (RUN(ph)) { REP(3) attn_phase(a, lds, l, rp_); }
        SEAM();
        if (RUN(ph)) { pg8::Gemm g{(const bf16_t*)(a.ws + WS_CAT), (const bf16_t*)(wl + WO_MO), D}; pg8::StaticOrder S; S.init(TOK, D, 2, G, bx, D / 2);
            pg8::EpiBf16 E{(bf16_t*)(a.ws + WS_Y), D, (size_t)TOK * D}; REP(7) pg8::gemm_phase(lds3, g, S, E); }
        SEAM();
        if (RUN(ph)) norm_phase(a, lds, vcu, NGW, false, true, l, 1, true, l, 2);
        SEAM();
        if (RUN(ph)) { pg8::Gemm g{(const bf16_t*)(a.ws + WS_H), (const bf16_t*)(wl + WO_GU2), D}; pg8::StaticOrder S; S.init(TOK, NGU, 1, G, bx, D);
            pg8::EpiSwiGLU E{(bf16_t*)(a.ws + WS_ACT)}; REP(5) pg8::gemm_phase(lds3, g, S, E); }
        SEAM();
        if (RUN(ph)) { pg8::Gemm g{(const bf16_t*)(a.ws + WS_ACT), (const bf16_t*)(wl + WO_D2), DFF}; pg8::StaticOrder S; S.init(TOK, D, 2, G, bx, DFF / 2);
            pg8::EpiBf16 E{(bf16_t*)(a.ws + WS_Y), D, (size_t)TOK * D}; REP(7) pg8::gemm_phase(lds3, g, S, E); }
        SEAM();
        if (RUN(ph)) norm_phase(a, lds, vcu, NGW, false, true, l, 2, l == 0, 1, 0);
        SEAM();
    }
#undef RUN
#undef SEAM
}

extern "C" void kernel_launch(void* const* d_in, const int* in_sizes, int n_in, void* d_out, int out_size, void* d_ws, size_t ws_size, hipStream_t stream) {
    static int grid = 0;
    if (grid == 0) {
        if (n_in != 33 || ws_size < WS_END) { fprintf(stderr, "kernel_launch: unexpected n_in %d / ws_size %zu\n", n_in, ws_size); grid = -1; return; }
        int dev = 0, cus = 0, per_cu = 0;
        (void)hipGetDevice(&dev);
        (void)hipDeviceGetAttribute(&cus, hipDeviceAttributeMultiprocessorCount, dev);
        if (hipFuncSetAttribute((const void*)fwd_kernel, hipFuncAttributeMaxDynamicSharedMemorySize, LDS_BYTES) != hipSuccess) { fprintf(stderr, "kernel_launch: hipFuncSetAttribute failed\n"); grid = -1; return; }
        if (hipOccupancyMaxActiveBlocksPerMultiprocessor(&per_cu, (const void*)fwd_kernel, 512, LDS_BYTES) != hipSuccess || per_cu < 1) { fprintf(stderr, "kernel_launch: occupancy query gave %d\n", per_cu); per_cu = 1; }
        (void)hipGetLastError();
        grid = cus * 1;
    }
    if (grid < 0) return;
    (void)hipMemsetAsync((char*)d_ws + WS_CTL, 0, 65536, stream);
    Args a{};
    for (int i = 0; i < 33; ++i) a.in[i] = (const float*)d_in[i];
    a.out = (float*)d_out; a.ws = (unsigned char*)d_ws; a.ph_lo = 0; a.ph_hi = 1000;
    void* args[] = {&a};
    hipError_t e = hipLaunchCooperativeKernel((const void*)fwd_kernel, dim3(grid), dim3(512), args, LDS_BYTES, stream);
    if (e != hipSuccess) fprintf(stderr, "kernel_launch: cooperative launch failed: %s (grid %d)\n", hipGetErrorString(e), grid);
}
```

```cpp
#include <hip/hip_runtime.h>
#include <hip/hip_cooperative_groups.h>
#include <cstdio>
#include <cstdint>
namespace cg = cooperative_groups;
#ifndef PROBE
#define PROBE 0
#endif
#define NREP(k) ((PROBE == (k)) ? 3 : 1)

typedef unsigned short bf16_t;
typedef short bf16x8 __attribute__((ext_vector_type(8)));
typedef float f32x4 __attribute__((ext_vector_type(4)));
typedef float f32x16 __attribute__((ext_vector_type(16)));
typedef unsigned u32x4 __attribute__((ext_vector_type(4)));
typedef unsigned u32x2 __attribute__((ext_vector_type(2)));
#define LAS __attribute__((address_space(3)))

constexpr int D = 1024, TOK = 8192, CTX_TOK = 4096, DFF = 2816, NGU = 5632, MIXIN = 2560;
constexpr int SEQ_C = 256, SEQ_L = 2048, S_LAT = 2304, NMOD = 9216;
constexpr float EPS = 1e-6f;
constexpr float LOG2E = 1.4426950408889634f;

constexpr size_t MiB = 1u << 20;
constexpr size_t WS_CTL = 0;
constexpr size_t WS_MODP = 64 * 1024;
constexpr size_t WS_W = 2 * MiB, WL = 40 * MiB;
constexpr size_t WO_GU1 = 0, WO_D1 = 11 * MiB, WO_GU2 = 16 * MiB + 512 * 1024, WO_D2 = 27 * MiB + 512 * 1024, WO_MI = 33 * MiB, WO_MO = 38 * MiB;
constexpr size_t WS_H = 82 * MiB, WS_CAT = 98 * MiB, WS_ACT = 114 * MiB, WS_Y = 158 * MiB;
constexpr size_t WS_QD = 222 * MiB, WS_QG = 226 * MiB;
constexpr size_t WS_KDC = 230 * MiB, WS_VDC = 232 * MiB, WS_KGC = 234 * MiB, WS_VGC = 235 * MiB;
constexpr size_t WS_KDL = 236 * MiB, WS_VDL = 239 * MiB, WS_KGL = 242 * MiB, WS_VGL = 244 * MiB, WS_TAB = 246 * MiB, WS_END = 247 * MiB;

constexpr int LDS_BYTES = 131072 + 12288 + 64;

__device__ __forceinline__ float wave_sum(float v) {
#pragma unroll
    for (int o = 1; o < 64; o <<= 1) v += __shfl_xor(v, o);
    return v;
}
__device__ __forceinline__ unsigned f2bf(float f) { unsigned u = __builtin_bit_cast(unsigned, f); return (u + 0x7fffu + ((u >> 16) & 1u)) >> 16; }
typedef float f32x2_cv __attribute__((ext_vector_type(2))); typedef __bf16 bf16x2_cv __attribute__((ext_vector_type(2)));
__device__ __forceinline__ unsigned pk2(float lo, float hi) { f32x2_cv v = {lo, hi}; bf16x2_cv b = __builtin_convertvector(v, bf16x2_cv); return __builtin_bit_cast(unsigned, b); }
__device__ __forceinline__ float bf2f(bf16_t h) { return __builtin_bit_cast(float, (unsigned)h << 16); }
__device__ __forceinline__ float silu_f(float v) { return v * __builtin_amdgcn_rcpf(1.0f + __builtin_amdgcn_exp2f(-1.4426950408889634f * v)); }
__device__ __forceinline__ int tid_now() { int t = threadIdx.x; asm volatile("" : "+v"(t)); return t; }

namespace pg8 {
constexpr int BM = 256, BK = 64, HALF = 128, HTB = HALF * BK * 2, NXCD = 8, WGM = 8;
__host__ __device__ __forceinline__ int lds_byte(int r, int c) { const int st = (r >> 4) * 2 + (c >> 5), rr = r & 15, cc = c & 31, ob = rr * 64 + cc * 2; return st * 1024 + (ob ^ (((ob >> 9) & 1) << 5)); }
__host__ __device__ __forceinline__ void stage_rc(int b, int& R, int& C) { const int st = b / 1024, sb = b % 1024, swz = sb ^ (((sb >> 9) & 1) << 5); R = (st >> 1) * 16 + swz / 64; C = (st & 1) * 32 + (swz % 64) / 2; }
__host__ __device__ __forceinline__ int perm32(int rho) { const int n = rho >> 4, i = rho & 15; return 8 * (i >> 2) + 4 * n + (i & 3); }

struct Unit { int pm, pn, ks, nt, koff; };
struct Gemm { const bf16_t* A; const bf16_t* Bt; int ld; };

struct StaticOrder {
    int nM, nN, nNr, nwg, G, c, Kloop;
    __device__ void init(int M, int N, int KS, int G_, int c_, int Kloop_) { nM = M / BM; nNr = N / BM; nN = nNr * KS; nwg = nM * nN; G = G_; c = c_; Kloop = Kloop_; }
    __device__ bool next(int i, Unit& u) const {
        const long L = (long)i * G + c; if (L >= nwg) return false;
        int wgid = (int)L; { const int q = nwg / NXCD, r = nwg % NXCD, xcd = wgid % NXCD, off = wgid / NXCD; wgid = (xcd < r ? xcd * (q + 1) : r * (q + 1) + (xcd - r) * q) + off; }
        const int nig = WGM * nN, gid = wgid / nig, fm = gid * WGM, gsz = (nM - fm) < WGM ? (nM - fm) : WGM;
        u.pm = fm + ((wgid % nig) % gsz); const int pv = (wgid % nig) / gsz; u.pn = pv % nNr; u.ks = pv / nNr; u.nt = Kloop / BK; u.koff = u.ks * Kloop * 2; return true;
    }
};

struct MixInOrder {
    StaticOrder S8; int G, c;
    __device__ void init(int G_, int c_) { S8.init(TOK, 2048, 1, G_, c_, D); G = G_; c = c_; }
    __device__ bool next(int i, Unit& u) const {
        const long L = (long)i * G + c;
        if (L < 256) return S8.next(i, u);
        if (L >= 512) return false;
        const int idx = (int)L - 256, r = idx & 7; u.pm = idx >> 3; u.pn = 8 + (r & 1); u.ks = r >> 1; u.nt = 4; u.koff = u.ks * 512; return true;
    }
};

__device__ __forceinline__ unsigned cvt_pk_bf16(float lo, float hi) { f32x2_cv v = {lo, hi}; bf16x2_cv b = __builtin_convertvector(v, bf16x2_cv); return __builtin_bit_cast(unsigned, b); }

struct EpiBf16 {
    static constexpr bool PERM = true;
    bf16_t* O; int ldc; size_t ks_stride;
    __device__ __forceinline__ void operator()(const f32x4 (&acc)[2][2][4][2], const Unit& u, int wr, int wc, int fr, int fq) const {
        bf16_t* Ob = O + (size_t)u.ks * ks_stride;
        const int row0 = u.pm * BM + wr * 64 + fr; const int col0 = u.pn * BM + wc * 32 + 8 * fq;
#pragma unroll
        for (int ai = 0; ai < 2; ++ai)
#pragma unroll
            for (int m = 0; m < 4; ++m) { bf16_t* rowp = Ob + (size_t)(row0 + ai * HALF + m * 16) * ldc + col0;
#pragma unroll
                for (int bj = 0; bj < 2; ++bj) { const f32x4 v0 = acc[ai][bj][m][0], v1 = acc[ai][bj][m][1];
                    u32x4 w; w.x = cvt_pk_bf16(v0[0], v0[1]); w.y = cvt_pk_bf16(v0[2], v0[3]); w.z = cvt_pk_bf16(v1[0], v1[1]); w.w = cvt_pk_bf16(v1[2], v1[3]);
                    *(u32x4*)(rowp + bj * HALF) = w; } }
    }
};
struct EpiMixIn {
    static constexpr bool PERM = true;
    bf16_t* PROJ; bf16_t* PART;
    __device__ __forceinline__ void operator()(const f32x4 (&acc)[2][2][4][2], const Unit& u, int wr, int wc, int fr, int fq) const {
        const bool part = u.pn >= 8;
        bf16_t* Ob = part ? PART + (size_t)u.ks * TOK * 512 : PROJ; const int ldc = part ? 512 : MIXIN;
        const int row0 = u.pm * BM + wr * 64 + fr; const int col0 = (part ? u.pn - 8 : u.pn) * BM + wc * 32 + 8 * fq;
#pragma unroll
        for (int ai = 0; ai < 2; ++ai)
#pragma unroll
            for (int m = 0; m < 4; ++m) { bf16_t* rowp = Ob + (size_t)(row0 + ai * HALF + m * 16) * ldc + col0;
#pragma unroll
                for (int bj = 0; bj < 2; ++bj) { const f32x4 v0 = acc[ai][bj][m][0], v1 = acc[ai][bj][m][1];
                    u32x4 w; w.x = cvt_pk_bf16(v0[0], v0[1]); w.y = cvt_pk_bf16(v0[2], v0[3]); w.z = cvt_pk_bf16(v1[0], v1[1]); w.w = cvt_pk_bf16(v1[2], v1[3]);
                    *(u32x4*)(rowp + bj * HALF) = w; } }
    }
};
struct EpiSwiGLU {
    static constexpr bool PERM = true;
    bf16_t* O;
    __device__ __forceinline__ void operator()(const f32x4 (&acc)[2][2][4][2], const Unit& u, int wr, int wc, int fr, int fq) const {
        const int row0 = u.pm * BM + wr * 64 + fr; const int col0 = u.pn * HALF + wc * 32 + 8 * fq;
#pragma unroll
        for (int ai = 0; ai < 2; ++ai)
#pragma unroll
            for (int m = 0; m < 4; ++m) { bf16_t* rowp = O + (size_t)(row0 + ai * HALF + m * 16) * DFF + col0;
                const f32x4 g0 = acc[ai][0][m][0], g1 = acc[ai][0][m][1], u0 = acc[ai][1][m][0], u1 = acc[ai][1][m][1];
                float r[8];
#pragma unroll
                for (int i = 0; i < 4; ++i) { r[i] = silu_f(g0[i]) * u0[i]; r[4 + i] = silu_f(g1[i]) * u1[i]; }
                u32x4 w; w.x = cvt_pk_bf16(r[0], r[1]); w.y = cvt_pk_bf16(r[2], r[3]); w.z = cvt_pk_bf16(r[4], r[5]); w.w = cvt_pk_bf16(r[6], r[7]);
                *(u32x4*)rowp = w; }
    }
};
struct EpiF32 {
    static constexpr bool PERM = false;
    float* O; int ldc; size_t ks_stride;
    __device__ __forceinline__ void operator()(const f32x4 (&acc)[2][2][4][2], const Unit& u, int wr, int wc, int fr, int fq) const {
        float* base = O + (size_t)u.ks * ks_stride;
        const int row0 = u.pm * BM + wr * 64 + fr; const int col0 = u.pn * BM + wc * 32 + 4 * fq;
#pragma unroll
        for (int ai = 0; ai < 2; ++ai)
#pragma unroll
            for (int m = 0; m < 4; ++m) { float* rowp = base + (size_t)(row0 + ai * HALF + m * 16) * ldc + col0;
#pragma unroll
                for (int bj = 0; bj < 2; ++bj)
#pragma unroll
                    for (int n = 0; n < 2; ++n) *(f32x4*)(rowp + bj * HALF + n * 16) = acc[ai][bj][m][n]; }
    }
};

template <class Epi, class Sched>
__device__ __forceinline__ void gemm_phase(LAS unsigned char* lds, const Gemm g, const Sched& S, const Epi& E) {
    const int tid = tid_now(), wid = __builtin_amdgcn_readfirstlane(tid >> 6), lane = tid & 63, wr = wid >> 2, wc = wid & 3, fr = lane & 15, fq = lane >> 4;
    const int K = g.ld;
    unsigned voffA[2], voffB[2];
#pragma unroll
    for (int i = 0; i < 2; ++i) { int R, C; stage_rc(tid * 16 + i * 8192, R, C); const int Rb = Epi::PERM ? ((R & ~31) + perm32(R & 31)) : R;
        voffA[i] = (unsigned)(R * K + C) * 2u; voffB[i] = (unsigned)(Rb * K + C) * 2u; }
    const size_t kstep = (size_t)(BK * 2);
    const size_t hstep = (size_t)HALF * K * 2;
    const size_t tstep = 2 * hstep;
    const unsigned ldsw = (unsigned)wid * 1024u;
    const int aoff = lds_byte(wr * 64 + fr, fq * 8), boff = lds_byte(wc * 32 + fr, fq * 8);
#define PG8_SA(b, h) (((b) * 2 + (h)) * HTB)
#define PG8_SB(b, h) ((4 + (b) * 2 + (h)) * HTB)
#define PG8_STAGE(bufoff, gbase, voff) do { _Pragma("unroll") for (int _i = 0; _i < 2; ++_i) \
        __builtin_amdgcn_global_load_lds((const unsigned*)((const char*)(gbase) + (voff)[_i]), (LAS unsigned*)(lds + (bufoff) + ldsw + _i * 8192), 16, 0, 0); } while (0)
#define PG8_LDA(dst, b, h) do { _Pragma("unroll") for (int m = 0; m < 4; ++m) _Pragma("unroll") for (int k = 0; k < 2; ++k) dst[m][k] = *(const LAS bf16x8*)(lds + PG8_SA(b, h) + aoff + m * 2048 + k * 1024); } while (0)
#define PG8_LDB(dst, b, h) do { _Pragma("unroll") for (int n = 0; n < 2; ++n) _Pragma("unroll") for (int k = 0; k < 2; ++k) dst[n][k] = *(const LAS bf16x8*)(lds + PG8_SB(b, h) + boff + n * 2048 + k * 1024); } while (0)
#define PG8_MMA(ai, bj, At, Bt) do { __builtin_amdgcn_s_setprio(1); _Pragma("unroll") for (int m = 0; m < 4; ++m) _Pragma("unroll") for (int n = 0; n < 2; ++n) _Pragma("unroll") for (int k = 0; k < 2; ++k) \
        acc[ai][bj][m][n] = __builtin_amdgcn_mfma_f32_16x16x32_bf16(Bt[n][k], At[m][k], acc[ai][bj][m][n], 0, 0, 0); __builtin_amdgcn_s_setprio(0); } while (0)
#define PG8_WAIT_V(n) asm volatile("s_waitcnt vmcnt(" #n ")" ::: "memory")
#define PG8_WAIT_L(n) asm volatile("s_waitcnt lgkmcnt(" #n ")" ::: "memory")
#define PG8_BAR __builtin_amdgcn_s_barrier()
#define PG8_SCHED __builtin_amdgcn_sched_barrier(0)
    Unit cur, nxt; int ui = 0;
    if (!S.next(0, cur)) return;
    f32x4 acc[2][2][4][2];
#pragma unroll
    for (int a = 0; a < 2; ++a)
#pragma unroll
        for (int b = 0; b < 2; ++b)
#pragma unroll
            for (int m = 0; m < 4; ++m)
#pragma unroll
                for (int n = 0; n < 2; ++n) acc[a][b][m][n] = (f32x4){0.f, 0.f, 0.f, 0.f};
    bf16x8 At[4][2], B0[2][2], B1[2][2];
    const char* cA = (const char*)g.A + (size_t)cur.pm * tstep + (size_t)cur.koff; const char* cB = (const char*)g.Bt + (size_t)cur.pn * tstep + (size_t)cur.koff;
    PG8_STAGE(PG8_SB(0, 0), cB, voffB); PG8_STAGE(PG8_SB(0, 1), cB + hstep, voffB); PG8_STAGE(PG8_SA(0, 0), cA, voffA); PG8_STAGE(PG8_SA(0, 1), cA + hstep, voffA);
    if (wr == 1) PG8_BAR;
    PG8_WAIT_V(2); PG8_BAR;
    PG8_STAGE(PG8_SB(1, 0), cB + kstep, voffB); PG8_STAGE(PG8_SA(1, 0), cA + kstep, voffA); PG8_STAGE(PG8_SB(1, 1), cB + hstep + kstep, voffB);
    PG8_WAIT_V(6); PG8_BAR;
    for (;;) {
        const bool has_next = S.next(ui + 1, nxt);
        const char* nA = has_next ? (const char*)g.A + (size_t)nxt.pm * tstep + (size_t)nxt.koff : cA; const char* nB = has_next ? (const char*)g.Bt + (size_t)nxt.pn * tstep + (size_t)nxt.koff : cB;
        const int nt = cur.nt;
        for (int t = 0; t < nt; t += 2) {
            const bool last = (t == nt - 2);
            const char* a1 = cA + (size_t)(t + 1) * kstep;
            const char* a2 = last ? nA : cA + (size_t)(t + 2) * kstep; const char* b2 = last ? nB : cB + (size_t)(t + 2) * kstep;
            const char* a3 = a2 + kstep; const char* b3 = b2 + kstep;
            PG8_LDB(B0, 0, 0); PG8_LDB(B1, 0, 1); PG8_SCHED; PG8_LDA(At, 0, 0); PG8_STAGE(PG8_SA(1, 1), a1 + hstep, voffA);
            PG8_WAIT_V(8); PG8_WAIT_L(0); PG8_BAR; PG8_MMA(0, 0, At, B0); PG8_MMA(0, 1, At, B1); PG8_BAR; PG8_SCHED;
            PG8_LDA(At, 0, 1); PG8_STAGE(PG8_SB(0, 0), b2, voffB); PG8_STAGE(PG8_SB(0, 1), b2 + hstep, voffB); PG8_STAGE(PG8_SA(0, 0), a2, voffA);
            PG8_WAIT_V(8); PG8_WAIT_L(0); PG8_BAR; PG8_MMA(1, 0, At, B0); PG8_MMA(1, 1, At, B1); PG8_BAR; PG8_SCHED;
            PG8_LDB(B0, 1, 0); PG8_LDB(B1, 1, 1); PG8_SCHED; PG8_LDA(At, 1, 0); PG8_STAGE(PG8_SA(0, 1), a2 + hstep, voffA);
            PG8_WAIT_V(8); PG8_WAIT_L(0); PG8_BAR; PG8_MMA(0, 0, At, B0); PG8_MMA(0, 1, At, B1); PG8_BAR; PG8_SCHED;
            PG8_LDA(At, 1, 1); PG8_STAGE(PG8_SB(1, 0), b3, voffB); PG8_STAGE(PG8_SB(1, 1), b3 + hstep, voffB); PG8_STAGE(PG8_SA(1, 0), a3, voffA);
            PG8_WAIT_V(8); PG8_WAIT_L(0); PG8_BAR; PG8_MMA(1, 0, At, B0); PG8_MMA(1, 1, At, B1); PG8_BAR; PG8_SCHED;
        }
        if (wr == 0) PG8_BAR;
        E(acc, cur, wr, wc, fr, fq);
        if (!has_next) break;
#pragma unroll
        for (int a = 0; a < 2; ++a)
#pragma unroll
            for (int b = 0; b < 2; ++b)
#pragma unroll
                for (int m = 0; m < 4; ++m)
#pragma unroll
                    for (int n = 0; n < 2; ++n) acc[a][b][m][n] = (f32x4){0.f, 0.f, 0.f, 0.f};
        cur = nxt; cA = nA; cB = nB; ++ui;
        if (wr == 1) PG8_BAR;
    }
    PG8_WAIT_V(0);
    PG8_BAR;
#undef PG8_SA
#undef PG8_SB
#undef PG8_STAGE
#undef PG8_LDA
#undef PG8_LDB
#undef PG8_MMA
#undef PG8_WAIT_V
#undef PG8_WAIT_L
#undef PG8_BAR
#undef PG8_SCHED
}
}

struct Args { const float* in[33]; float* out; unsigned char* ws; int ph_lo, ph_hi; };
enum { I_XP = 0, I_XS, I_CDK, I_CDV, I_CGK, I_CGV, I_C, I_CCTX, I_WADA, I_BADA, I_NPRE, I_NPOST, I_F1G, I_F1U, I_F1D, I_F2G, I_F2U, I_F2D,
       I_WMI, I_WMO, I_SCW, I_LQ1, I_LK1, I_LQ2, I_LK2, I_SUBLN, I_CDWW, I_CDWB, I_CLNG, I_CLNB, I_CPW, I_QNORM, I_KNORM };

__device__ __forceinline__ const float* inptr(int i) {
    typedef const char __attribute__((address_space(4)))* kptr_t;
    kptr_t kp = (kptr_t)__builtin_amdgcn_kernarg_segment_ptr();
    unsigned off = 8u * (unsigned)i; asm volatile("" : "+s"(off));
    return *(const float* const __attribute__((address_space(4)))*)(kp + off);
}
__device__ __forceinline__ void tr_item(const float* W, int ldw, bf16_t* WT, int ldt, int k0, int n0, int orow0, float* scr, int lane) {
    f32x4 v[8];
    const int lr = lane >> 3, lc = (lane & 7) * 4;
#pragma unroll
    for (int i = 0; i < 8; ++i) v[i] = *(const f32x4*)(W + (size_t)(k0 + 8 * i + lr) * ldw + n0 + lc);
#pragma unroll
    for (int i = 0; i < 8; ++i) { float* d = scr + (8 * i + lr) * 33 + lc; d[0] = v[i][0]; d[1] = v[i][1]; d[2] = v[i][2]; d[3] = v[i][3]; }
    asm volatile("s_waitcnt lgkmcnt(0)" ::: "memory");
    const int c = lane & 7;
#pragma unroll
    for (int j = 0; j < 4; ++j) { const int n = (lane >> 3) + 8 * j; const float* s = scr + (8 * c) * 33 + n;
        u32x4 o; o.x = pk2(s[0 * 33], s[1 * 33]); o.y = pk2(s[2 * 33], s[3 * 33]); o.z = pk2(s[4 * 33], s[5 * 33]); o.w = pk2(s[6 * 33], s[7 * 33]);
        *(u32x4*)(WT + (size_t)(orow0 + n) * ldt + k0 + 8 * c) = o; }
    asm volatile("s_waitcnt lgkmcnt(0)" ::: "memory");
}

__device__ __forceinline__ void p0_prologue(const Args& a, unsigned char* lds, int vcu, int NGW) {
    const int tid = tid_now(), lane = tid & 63, wave = __builtin_amdgcn_readfirstlane(tid >> 6), gw = vcu * 8 + wave;
    float* SC = (float*)(lds + 131072);
    for (int i = tid; i < 3 * 1024; i += 512) { const int c = i >> 10, k = i & 1023; const float v = (c == 0) ? inptr(I_CCTX)[k] : inptr(I_C)[(c - 1) * 1024 + k]; SC[i] = silu_f(v); }
    __syncthreads();
    float* scr = (float*)(lds + wave * 16384);
    float* MODP = (float*)(a.ws + WS_MODP);
    constexpr int N_ADA = 2304, N_FOLD = 1024, N_TRL = 10112, N_TR = 2 * N_TRL, NIT = N_ADA + N_FOLD + N_TR;
    for (int it = gw; it < NIT; it += NGW) {
        if (it < N_ADA) {
            const int l = it / 1152, r2 = it % 1152, cb = r2 >> 3, kc = r2 & 7, col = cb * 64 + lane;
            const float* W = inptr(I_WADA) + (size_t)l * 1024 * NMOD + (size_t)(kc * 128) * NMOD + col;
            const float* s0 = SC + kc * 128;
            float a0 = 0.f, a1 = 0.f, a2 = 0.f;
#pragma unroll 32
            for (int k = 0; k < 128; ++k) { const float w = W[(size_t)k * NMOD]; a0 += s0[k] * w; a1 += s0[1024 + k] * w; a2 += s0[2048 + k] * w; }
            float* o = MODP + (size_t)((l * 8 + kc) * 3) * NMOD + col;
            o[0] = a0; o[NMOD] = a1; o[2 * NMOD] = a2;
        } else if (it < N_ADA + N_FOLD) {
            const int r = it - N_ADA, l = r >> 9, r2 = r & 511, kg = r2 >> 4, nb = r2 & 15, k0 = kg * 8, n = nb * 64 + lane;
            const float* pw = inptr(I_CPW) + (size_t)l * 65536 + (size_t)k0 * 256;
            const float* wm = inptr(I_WMO) + (size_t)l * 1048576 + (size_t)512 * 1024 + n;
            float acc[8];
#pragma unroll
            for (int q = 0; q < 8; ++q) acc[q] = 0.f;
#pragma unroll 16
            for (int j = 0; j < 256; ++j) { const float wv = wm[(size_t)j * 1024];
#pragma unroll
                for (int q = 0; q < 8; ++q) acc[q] += pw[q * 256 + j] * wv; }
            bf16_t* WT = (bf16_t*)(a.ws + WS_W + l * WL + WO_MO);
            u32x4 o; o.x = pk2(acc[0], acc[1]); o.y = pk2(acc[2], acc[3]); o.z = pk2(acc[4], acc[5]); o.w = pk2(acc[6], acc[7]);
            *(u32x4*)(WT + (size_t)n * 1024 + 512 + k0) = o;
        } else {
            int r = it - N_ADA - N_FOLD; const int l = r / N_TRL; r %= N_TRL;
            unsigned char* wl = a.ws + WS_W + l * WL;
            if (r < 8448) {
                const int which = r / 1408, q = r % 1408;
                const int ffn = which / 3, kind = which % 3;
                const float* W = inptr((ffn ? I_F2G : I_F1G) + kind) + (size_t)l * 1024 * DFF;
                if (kind < 2) { const int kb = q / 88, nb = q % 88, n0 = nb * 32;
                    tr_item(W, DFF, (bf16_t*)(wl + (ffn ? WO_GU2 : WO_GU1)), 1024, kb * 64, n0, (n0 >> 7) * 256 + (n0 & 127) + kind * 128, scr, lane); }
                else { const int kb = q / 32, nb = q % 32;
                    tr_item(W, 1024, (bf16_t*)(wl + (ffn ? WO_D2 : WO_D1)), DFF, kb * 64, nb * 32, nb * 32, scr, lane); }
            } else if (r < 8448 + 1280) { const int q = r - 8448, kb = q / 80, nb = q % 80;
                tr_item(inptr(I_WMI) + (size_t)l * 1024 * MIXIN, MIXIN, (bf16_t*)(wl + WO_MI), 1024, kb * 64, nb * 32, nb * 32, scr, lane);
            } else { const int q = r - 9728, kbi = q / 32, nb = q % 32, kb = kbi < 8 ? kbi : kbi + 4;
                tr_item(inptr(I_WMO) + (size_t)l * 1048576, 1024, (bf16_t*)(wl + WO_MO), 1024, kb * 64, nb * 32, nb * 32, scr, lane);
            }
        }
    }
}

__device__ __forceinline__ void mod_finalize(const Args& a, int vcu, int G) {
    const int tid = tid_now();
    const float* MODP = (const float*)(a.ws + WS_MODP); float* TAB = (float*)(a.ws + WS_TAB);
    const float* bada = inptr(I_BADA); const float* npost = inptr(I_NPOST); const float* npre = inptr(I_NPRE);
    for (int idx = vcu * 512 + tid; idx < 2 * 27 * 1024; idx += G * 512) {
        const int j = idx & 1023; int t = idx >> 10; const int c = t % 3; t /= 3; const int kind = t % 3; t /= 3; const int i = t % 3, l = t / 3;
        const int mi = kind == 0 ? 3 * i + 2 : (kind == 1 ? 3 * i + 1 : 3 * i);
        float v = bada[(size_t)l * NMOD + mi * 1024 + j];
#pragma unroll
        for (int kc = 0; kc < 8; ++kc) v += MODP[(size_t)((l * 8 + kc) * 3 + c) * NMOD + mi * 1024 + j];
        const float gs = (i == 1) ? 1.0f : 0.5f;
        TAB[idx] = kind == 0 ? gs * v * npost[(l * 3 + i) * 1024 + j] : (kind == 1 ? (1.0f + v) * npre[(l * 3 + i) * 1024 + j] : v);
    }
}

__device__ __forceinline__ void norm_phase(const Args& a, unsigned char* lds, int vcu, int NGW,
                                           bool first, bool has_prev, int lp, int ip, bool has_next, int ln, int in_, bool dry = false) {
    const int tid = tid_now(), lane = tid & 63, wave = __builtin_amdgcn_readfirstlane(tid >> 6), gw = vcu * 8 + wave;
    float* MV = (float*)lds;
    const float* TAB = (const float*)(a.ws + WS_TAB);
    __syncthreads();
    for (int idx = tid * 4; idx < 9216; idx += 2048) {
        const int kind = idx / 3072, rem = idx % 3072;
        const int l = kind == 0 ? lp : ln, i = kind == 0 ? ip : in_;
        f32x4 v = (f32x4){0.f, 0.f, 0.f, 0.f};
        if (kind == 0 ? has_prev : has_next) v = *(const f32x4*)(TAB + (size_t)(((l * 3 + i) * 3 + kind) * 3) * 1024 + rem);
        *(f32x4*)(MV + idx) = v;
    }
    __syncthreads();
    float* X = a.out; float* XO = dry ? (float*)(a.ws + WS_ACT) : a.out;
    const bf16_t* Y0 = (const bf16_t*)(a.ws + WS_Y); const bf16_t* Y1 = Y0 + (size_t)TOK * D;
    bf16_t* H = (bf16_t*)(a.ws + (dry ? WS_CAT : WS_H));
    const float* xp = inptr(I_XP); const float* xsm = inptr(I_XS);
    constexpr int R = 4;
    const int co = 8 * lane;
    for (int r0 = gw; r0 < TOK; r0 += R * NGW) {
        f32x4 x[R][4]; u32x4 ya[R][2], yb[R][2];
#pragma unroll
        for (int rr = 0; rr < R; ++rr) { const int row = r0 + rr * NGW;
            if (row < TOK) {
                const float* xs = first ? (row < CTX_TOK ? xp + (size_t)row * D : xsm + (size_t)(row - CTX_TOK) * D) : X + (size_t)row * D;
#pragma unroll
                for (int j = 0; j < 2; ++j) { x[rr][2 * j] = *(const f32x4*)(xs + co + 512 * j); x[rr][2 * j + 1] = *(const f32x4*)(xs + co + 512 * j + 4); }
                if (has_prev) {
#pragma unroll
                    for (int j = 0; j < 2; ++j) { ya[rr][j] = *(const u32x4*)(Y0 + (size_t)row * D + co + 512 * j); yb[rr][j] = *(const u32x4*)(Y1 + (size_t)row * D + co + 512 * j); }
                }
            } }
#pragma unroll
        for (int rr = 0; rr < R; ++rr) { const int row = r0 + rr * NGW;
            if (row < TOK) {
                const int c = row < CTX_TOK ? 0 : (row < CTX_TOK + SEQ_L ? 1 : 2);
                if (has_prev) {
                    f32x4 y[4]; float s = 0.f;
#pragma unroll
                    for (int j = 0; j < 2; ++j) {
#pragma unroll
                        for (int q = 0; q < 4; ++q) { const unsigned wa = ya[rr][j][q], wb = yb[rr][j][q];
                            const float lo = __builtin_bit_cast(float, wa << 16) + __builtin_bit_cast(float, wb << 16);
                            const float hi = __builtin_bit_cast(float, wa & 0xffff0000u) + __builtin_bit_cast(float, wb & 0xffff0000u);
                            y[2 * j + (q >> 1)][2 * (q & 1)] = lo; y[2 * j + (q >> 1)][2 * (q & 1) + 1] = hi; s += lo * lo + hi * hi; } }
                    const float ry = rsqrtf(wave_sum(s) * (1.0f / D) + EPS);
#pragma unroll
                    for (int j = 0; j < 2; ++j)
#pragma unroll
                        for (int h2 = 0; h2 < 2; ++h2) { const f32x4 gp = *(const f32x4*)(MV + c * 1024 + co + 512 * j + 4 * h2); x[rr][2 * j + h2] = x[rr][2 * j + h2] + gp * y[2 * j + h2] * ry; }
                }
                if (has_prev) {
#pragma unroll
                    for (int j = 0; j < 2; ++j) { *(f32x4*)(XO + (size_t)row * D + co + 512 * j) = x[rr][2 * j]; *(f32x4*)(XO + (size_t)row * D + co + 512 * j + 4) = x[rr][2 * j + 1]; }
                }
                if (has_next) {
                    float s = 0.f;
#pragma unroll
                    for (int q = 0; q < 4; ++q) s += (x[rr][q][0] * x[rr][q][0] + x[rr][q][1] * x[rr][q][1]) + (x[rr][q][2] * x[rr][q][2] + x[rr][q][3] * x[rr][q][3]);
                    const float rx = rsqrtf(wave_sum(s) * (1.0f / D) + EPS);
#pragma unroll
                    for (int j = 0; j < 2; ++j) {
                        const f32x4 a0 = *(const f32x4*)(MV + 3072 + c * 1024 + co + 512 * j), a1 = *(const f32x4*)(MV + 3072 + c * 1024 + co + 512 * j + 4);
                        const f32x4 s0 = *(const f32x4*)(MV + 6144 + c * 1024 + co + 512 * j), s1 = *(const f32x4*)(MV + 6144 + c * 1024 + co + 512 * j + 4);
                        const f32x4 h0 = x[rr][2 * j] * rx * a0 + s0, h1 = x[rr][2 * j + 1] * rx * a1 + s1;
                        u32x4 w; w.x = pg8::cvt_pk_bf16(h0[0], h0[1]); w.y = pg8::cvt_pk_bf16(h0[2], h0[3]); w.z = pg8::cvt_pk_bf16(h1[0], h1[1]); w.w = pg8::cvt_pk_bf16(h1[2], h1[3]);
                        *(u32x4*)(H + (size_t)row * D + co + 512 * j) = w; }
                }
            } }
    }
}

__device__ __forceinline__ void rope_pair(float& x, float xp, float ang, bool second) {
    const float s = __sinf(ang), c = __cosf(ang);
    x = second ? (xp * s + x * c) : (x * c - xp * s);
}
__device__ __forceinline__ float bflo(unsigned w) { return __builtin_bit_cast(float, w << 16); }
__device__ __forceinline__ float bfhi(unsigned w) { return __builtin_bit_cast(float, w & 0xffff0000u); }
__device__ __forceinline__ void mix_prep(const Args& a, unsigned char* lds, int l) {
    const int tid = tid_now(), lane = tid & 63, wave = __builtin_amdgcn_readfirstlane(tid >> 6);
    const bf16_t* PROJ = (const bf16_t*)(a.ws + WS_ACT);
    bf16_t* CAT = (bf16_t*)(a.ws + WS_CAT);
    bf16_t* QD = (bf16_t*)(a.ws + WS_QD); bf16_t* QG = (bf16_t*)(a.ws + WS_QG);
    float* U = (float*)lds;
    float* VB = (float*)(lds + 65536);
    const float qs_d = 0.17677669529663687f * LOG2E, qs_g = 0.125f * LOG2E;
    const float L2T = 13.287712379549449f;
    float invd[4], invg[4], invk[2];
#pragma unroll
    for (int t = 0; t < 4; ++t) { invd[t] = exp2f(-(float)(4 * (lane & 1) + t) * (L2T / 8.0f)); invg[t] = exp2f(-(float)(4 * (lane & 3) + t) * (L2T / 16.0f)); }
#pragma unroll
    for (int t = 0; t < 2; ++t) invk[t] = exp2f(-(float)(2 * (lane & 7) + t) * (L2T / 16.0f));
    for (int tile = blockIdx.x; tile < TOK / 32; tile += gridDim.x) {
        const int row0 = tile * 32; const bool lat = row0 >= CTX_TOK;
        int seq, pos0, seqlen;
        if (!lat) { seq = row0 / SEQ_C; pos0 = row0 % SEQ_C; seqlen = SEQ_C; } else { seq = (row0 - CTX_TOK) / SEQ_L; pos0 = (row0 - CTX_TOK) % SEQ_L; seqlen = SEQ_L; }
        bf16_t* KD = lat ? (bf16_t*)(a.ws + WS_KDL) + (size_t)(seq * S_LAT + 256) * 256 : (bf16_t*)(a.ws + WS_KDC) + (size_t)(seq * SEQ_C) * 256;
        bf16_t* VD = lat ? (bf16_t*)(a.ws + WS_VDL) + (size_t)(seq * S_LAT + 256) * 256 : (bf16_t*)(a.ws + WS_VDC) + (size_t)(seq * SEQ_C) * 256;
        bf16_t* KG = lat ? (bf16_t*)(a.ws + WS_KGL) + (size_t)(seq * S_LAT + 256) * 128 : (bf16_t*)(a.ws + WS_KGC) + (size_t)(seq * SEQ_C) * 128;
        bf16_t* VG = lat ? (bf16_t*)(a.ws + WS_VGL) + (size_t)(seq * S_LAT + 256) * 128 : (bf16_t*)(a.ws + WS_VGC) + (size_t)(seq * SEQ_C) * 128;
#pragma unroll 1
        for (int hh = 0; hh < 1; ++hh) {
            const int row_b = row0 + wave * 4, pos_b = pos0 + wave * 4;
            u32x2 dq[4], dk[4], dv[4], gqp[4][4], ab[4], ac[6], ah[6]; unsigned gkp[4][4], gvp[4][4];
#pragma unroll
            for (int rr = 0; rr < 4; ++rr) { const bf16_t* pr = PROJ + (size_t)(row_b + rr) * MIXIN;
                dq[rr] = *(const u32x2*)(pr + 768 + 4 * lane); dk[rr] = *(const u32x2*)(pr + 1024 + 4 * lane); dv[rr] = *(const u32x2*)(pr + 1280 + 4 * lane);
                ab[rr] = *(const u32x2*)(pr + 4 * lane); }
#pragma unroll
            for (int t = 0; t < 6; ++t) { const int tp = pos_b - 1 + t; const bool valid = tp >= 0 && tp < seqlen; const bf16_t* pr = PROJ + (size_t)(row_b - 1 + t) * MIXIN;
                ac[t] = (u32x2){0u, 0u}; ah[t] = (u32x2){0u, 0u};
                if (valid) { ac[t] = *(const u32x2*)(pr + 256 + 4 * lane); ah[t] = *(const u32x2*)(pr + 512 + 4 * lane); } }
#pragma unroll
            for (int rr = 0; rr < 4; ++rr) { const int row = row_b + rr, pos = pos_b + rr;
                float q[4] = {bflo(dq[rr].x), bfhi(dq[rr].x), bflo(dq[rr].y), bfhi(dq[rr].y)};
                float k[4] = {bflo(dk[rr].x), bfhi(dk[rr].x), bflo(dk[rr].y), bfhi(dk[rr].y)};
                if (lat) {
                    const float pax = (float)((lane & 4) ? (pos & 63) : (pos >> 6)); const bool second = (lane & 2) != 0;
#pragma unroll
                    for (int t = 0; t < 4; ++t) { const float ang = pax * invd[t]; const float sn = __sinf(ang), cs = __cosf(ang);
                        const float qp = __shfl_xor(q[t], 2), kp = __shfl_xor(k[t], 2);
                        q[t] = second ? (qp * sn + q[t] * cs) : (q[t] * cs - qp * sn); k[t] = second ? (kp * sn + k[t] * cs) : (k[t] * cs - kp * sn); }
                } else {
                    float* odk = a.out + 8388608 + ((size_t)(seq * 2 + l) * 256 + pos) * 256 + 4 * lane;
                    float* odv = a.out + 10485760 + ((size_t)(seq * 2 + l) * 256 + pos) * 256 + 4 * lane;
                    *(f32x4*)odk = (f32x4){k[0], k[1], k[2], k[3]};
                    *(f32x4*)odv = (f32x4){bflo(dv[rr].x), bfhi(dv[rr].x), bflo(dv[rr].y), bfhi(dv[rr].y)};
                }
                u32x2 w; w.x = pg8::cvt_pk_bf16(q[0] * qs_d, q[1] * qs_d); w.y = pg8::cvt_pk_bf16(q[2] * qs_d, q[3] * qs_d);
                *(u32x2*)(QD + (size_t)row * 256 + 4 * lane) = w;
                w.x = pg8::cvt_pk_bf16(k[0], k[1]); w.y = pg8::cvt_pk_bf16(k[2], k[3]);
                *(u32x2*)(KD + (size_t)pos * 256 + 4 * lane) = w;
                *(u32x2*)(VD + (size_t)pos * 256 + 4 * lane) = dv[rr];
            }
            {
                f32x4 scw[3];
#pragma unroll
                for (int k = 0; k < 3; ++k) scw[k] = *(const f32x4*)(inptr(I_SCW) + (l * 3 + k) * 256 + 4 * lane);
                float pr6[6][4];
#pragma unroll
                for (int t = 0; t < 6; ++t) { pr6[t][0] = bflo(ac[t].x) * bflo(ah[t].x); pr6[t][1] = bfhi(ac[t].x) * bfhi(ah[t].x); pr6[t][2] = bflo(ac[t].y) * bflo(ah[t].y); pr6[t][3] = bfhi(ac[t].y) * bfhi(ah[t].y); }
#pragma unroll
                for (int rr = 0; rr < 4; ++rr) {
                    float o[4]; const float b4[4] = {bflo(ab[rr].x), bfhi(ab[rr].x), bflo(ab[rr].y), bfhi(ab[rr].y)};
#pragma unroll
                    for (int e = 0; e < 4; ++e) o[e] = b4[e] * (scw[0][e] * pr6[rr][e] + scw[1][e] * pr6[rr + 1][e] + scw[2][e] * pr6[rr + 2][e]);
                    u32x2 w; w.x = pg8::cvt_pk_bf16(o[0], o[1]); w.y = pg8::cvt_pk_bf16(o[2], o[3]);
                    *(u32x2*)(CAT + (size_t)(row_b + rr) * D + 4 * lane) = w;
                }
            }
            asm volatile("" ::: "memory");
            const bf16_t* PART = (const bf16_t*)(a.ws + WS_Y);
#pragma unroll
            for (int rr = 0; rr < 4; ++rr)
#pragma unroll
                for (int ks = 0; ks < 4; ++ks) { const bf16_t* pp = PART + ((size_t)ks * TOK + row_b + rr) * 512;
                    gqp[rr][ks] = *(const u32x2*)(pp + 4 * lane); gkp[rr][ks] = *(const unsigned*)(pp + 256 + 2 * lane); gvp[rr][ks] = *(const unsigned*)(pp + 384 + 2 * lane); }
            const f32x4 qnv = *(const f32x4*)(inptr(I_QNORM) + l * 64 + 4 * (lane & 15));
#pragma unroll
            for (int rr = 0; rr < 4; ++rr) { const int row = row_b + rr, pos = pos_b + rr;
                float q[4] = {0.f, 0.f, 0.f, 0.f};
#pragma unroll
                for (int ks = 0; ks < 4; ++ks) { q[0] += bflo(gqp[rr][ks].x); q[1] += bfhi(gqp[rr][ks].x); q[2] += bflo(gqp[rr][ks].y); q[3] += bfhi(gqp[rr][ks].y); }
                float ss = (q[0] * q[0] + q[1] * q[1]) + (q[2] * q[2] + q[3] * q[3]);
                ss += __shfl_xor(ss, 1); ss += __shfl_xor(ss, 2); ss += __shfl_xor(ss, 4); ss += __shfl_xor(ss, 8);
                const float rn = rsqrtf(ss * (1.0f / 64.0f) + EPS);
#pragma unroll
                for (int t = 0; t < 4; ++t) q[t] = q[t] * rn * qnv[t];
                if (lat) {
                    const float pax = (float)((lane & 8) ? (pos & 63) : (pos >> 6)); const bool second = (lane & 4) != 0;
#pragma unroll
                    for (int t = 0; t < 4; ++t) { const float ang = pax * invg[t]; const float sn = __sinf(ang), cs = __cosf(ang);
                        const float qp = __shfl_xor(q[t], 4);
                        q[t] = second ? (qp * sn + q[t] * cs) : (q[t] * cs - qp * sn); }
                }
                u32x2 w; w.x = pg8::cvt_pk_bf16(q[0] * qs_g, q[1] * qs_g); w.y = pg8::cvt_pk_bf16(q[2] * qs_g, q[3] * qs_g);
                *(u32x2*)(QG + (size_t)row * 256 + 4 * lane) = w;
            }
            const float kn0 = inptr(I_KNORM)[l * 64 + 2 * (lane & 31)], kn1 = inptr(I_KNORM)[l * 64 + 2 * (lane & 31) + 1];
#pragma unroll
            for (int rr = 0; rr < 4; ++rr) { const int pos = pos_b + rr;
                float k0 = 0.f, k1 = 0.f, v0 = 0.f, v1 = 0.f;
#pragma unroll
                for (int ks = 0; ks < 4; ++ks) { k0 += bflo(gkp[rr][ks]); k1 += bfhi(gkp[rr][ks]); v0 += bflo(gvp[rr][ks]); v1 += bfhi(gvp[rr][ks]); }
                const unsigned vpk = pg8::cvt_pk_bf16(v0, v1);
                float ss = k0 * k0 + k1 * k1;
                ss += __shfl_xor(ss, 1); ss += __shfl_xor(ss, 2); ss += __shfl_xor(ss, 4); ss += __shfl_xor(ss, 8); ss += __shfl_xor(ss, 16);
                const float rn = rsqrtf(ss * (1.0f / 64.0f) + EPS);
                k0 = k0 * rn * kn0; k1 = k1 * rn * kn1;
                if (lat) {
                    const float pax = (float)((lane & 16) ? (pos & 63) : (pos >> 6)); const bool second = (lane & 8) != 0;
                    const float a0 = pax * invk[0], a1 = pax * invk[1];
                    const float s0 = __sinf(a0), c0 = __cosf(a0), s1 = __sinf(a1), c1 = __cosf(a1);
                    const float p0 = __shfl_xor(k0, 8), p1 = __shfl_xor(k1, 8);
                    k0 = second ? (p0 * s0 + k0 * c0) : (k0 * c0 - p0 * s0); k1 = second ? (p1 * s1 + k1 * c1) : (k1 * c1 - p1 * s1);
                } else {
                    float* ogk = a.out + 12582912 + ((size_t)(seq * 2 + l) * 256 + pos) * 128 + 2 * lane;
                    float* ogv = a.out + 13631488 + ((size_t)(seq * 2 + l) * 256 + pos) * 128 + 2 * lane;
                    typedef float f32x2 __attribute__((ext_vector_type(2)));
                    *(f32x2*)ogk = (f32x2){k0, k1}; *(f32x2*)ogv = (f32x2){bflo(vpk), bfhi(vpk)};
                }
                *(unsigned*)(KG + (size_t)pos * 128 + 2 * lane) = pg8::cvt_pk_bf16(k0, k1);
                *(unsigned*)(VG + (size_t)pos * 128 + 2 * lane) = vpk;
            }
        }
        if (wave < 2) {
            const int id = tile * 2 + wave, b = id >> 8, p = id & 255;
            const size_t src = ((size_t)(b * 2 + l) * 256 + p);
            typedef float f32x2 __attribute__((ext_vector_type(2)));
            const f32x4 ck = *(const f32x4*)(inptr(I_CDK) + src * 256 + 4 * lane), cv = *(const f32x4*)(inptr(I_CDV) + src * 256 + 4 * lane);
            const f32x2 gkk = *(const f32x2*)(inptr(I_CGK) + src * 128 + 2 * lane), gvv = *(const f32x2*)(inptr(I_CGV) + src * 128 + 2 * lane);
            u32x2 w; w.x = pg8::cvt_pk_bf16(ck[0], ck[1]); w.y = pg8::cvt_pk_bf16(ck[2], ck[3]);
            *(u32x2*)((bf16_t*)(a.ws + WS_KDL) + (size_t)(b * S_LAT + p) * 256 + 4 * lane) = w;
            w.x = pg8::cvt_pk_bf16(cv[0], cv[1]); w.y = pg8::cvt_pk_bf16(cv[2], cv[3]);
            *(u32x2*)((bf16_t*)(a.ws + WS_VDL) + (size_t)(b * S_LAT + p) * 256 + 4 * lane) = w;
            *(unsigned*)((bf16_t*)(a.ws + WS_KGL) + (size_t)(b * S_LAT + p) * 128 + 2 * lane) = pg8::cvt_pk_bf16(gkk[0], gkk[1]);
            *(unsigned*)((bf16_t*)(a.ws + WS_VGL) + (size_t)(b * S_LAT + p) * 128 + 2 * lane) = pg8::cvt_pk_bf16(gvv[0], gvv[1]);
        }
        __syncthreads();
        {
            const int cp = tid & 127, rg = tid >> 7;
            unsigned ca[16], cgv[16];
#pragma unroll
            for (int i = 0; i < 16; ++i) { const int r = rg + 4 * i, tp = pos0 - 15 + r; ca[i] = 0u; cgv[i] = 0u;
                if (r < 62 && tp >= 0 && tp < seqlen) { const bf16_t* p2 = PROJ + (size_t)(row0 - 15 + r) * MIXIN; ca[i] = *(const unsigned*)(p2 + 1536 + 2 * cp); cgv[i] = *(const unsigned*)(p2 + 1792 + 2 * cp); } }
#pragma unroll
            for (int i = 0; i < 16; ++i) { const int r = rg + 4 * i;
                if (r < 62) { typedef float f32x2 __attribute__((ext_vector_type(2)));
                    const float u0 = bflo(ca[i]) * __builtin_amdgcn_rcpf(1.0f + __builtin_amdgcn_exp2f(-LOG2E * bflo(cgv[i]))), u1 = bfhi(ca[i]) * __builtin_amdgcn_rcpf(1.0f + __builtin_amdgcn_exp2f(-LOG2E * bfhi(cgv[i])));
                    *(f32x2*)(U + r * 256 + 2 * cp) = (f32x2){u0, u1}; } }
        }
        __syncthreads();
        {
            const int c = tid & 255, half = tid >> 8;
            float w[31], acc[16];
#pragma unroll
            for (int k = 0; k < 31; ++k) w[k] = inptr(I_CDWW)[(l * 31 + k) * 256 + c];
            const float bias = inptr(I_CDWB)[l * 256 + c];
#pragma unroll
            for (int o = 0; o < 16; ++o) acc[o] = bias;
#pragma unroll
            for (int i = 0; i < 46; ++i) { const float u = U[(16 * half + i) * 256 + c];
#pragma unroll
                for (int o = 0; o < 16; ++o) { const int k = i - o; if (k >= 0 && k < 31) acc[o] += w[k] * u; } }
#pragma unroll
            for (int o = 0; o < 16; ++o) VB[(16 * half + o) * 256 + c] = acc[o];
        }
        __syncthreads();
        const f32x4 lng = *(const f32x4*)(inptr(I_CLNG) + l * 256 + 4 * lane), lnb = *(const f32x4*)(inptr(I_CLNB) + l * 256 + 4 * lane);
#pragma unroll
        for (int rr = 0; rr < 4; ++rr) {
            const int rl = wave * 4 + rr, row = row0 + rl;
            f32x4 v = *(const f32x4*)(VB + rl * 256 + 4 * lane);
            const float mu = wave_sum((v[0] + v[1]) + (v[2] + v[3])) * (1.0f / 256.0f);
            v = v - mu;
            const float rstd = rsqrtf(wave_sum((v[0] * v[0] + v[1] * v[1]) + (v[2] * v[2] + v[3] * v[3])) * (1.0f / 256.0f) + EPS);
            const f32x4 y = v * rstd * lng + lnb;
            u32x2 w; w.x = pg8::cvt_pk_bf16(silu_f(y[0]), silu_f(y[1])); w.y = pg8::cvt_pk_bf16(silu_f(y[2]), silu_f(y[3]));
            *(u32x2*)(CAT + (size_t)row * D + 512 + 4 * lane) = w;
        }
        __syncthreads();
    }
}

constexpr int AT_KB = 64 * 144;
constexpr int AT_K0 = 0, AT_V0 = 2 * AT_KB, AT_XCH = 40960;
template <int DK>
__device__ __forceinline__ void attn_unit(unsigned char* lds, const Args& a, int l, bool is_diff, int hidx, int qrow0, const bf16_t* Kp, const bf16_t* Vp, int ldkv, int S) {
    const int tid = tid_now(), lane = tid & 63, wave = __builtin_amdgcn_readfirstlane(tid >> 6), sub = wave >> 2, wq = wave & 3, r32 = lane & 31, hi = lane >> 5;
    const int kcol = hidx * 64;
    const int kcsub = is_diff ? sub * 32 : 0;
    const bf16_t* Qp = is_diff ? (const bf16_t*)(a.ws + WS_QD) + hidx * 64 + sub * 32 : (const bf16_t*)(a.ws + WS_QG) + (2 * hidx + sub) * 64;
    const int qrow = qrow0 + wq * 32 + r32;
    bf16x8 qf[DK / 16];
#pragma unroll
    for (int d0 = 0; d0 < DK / 16; ++d0) qf[d0] = *(const bf16x8*)(Qp + (size_t)qrow * 256 + d0 * 16 + hi * 8);
    const int sr = tid & 63, sch = tid >> 6;
    const bf16_t* kg = Kp + (size_t)sr * ldkv + kcol + sch * 8; const bf16_t* vg = Vp + (size_t)sr * ldkv + kcol + sch * 8;
    const int o16 = sr & 15; const int vcol = 16 * (sr >> 4) + 8 * ((o16 >> 2) & 1) + (o16 & 3) + 4 * (o16 >> 3);
    u32x4 kreg = *(const u32x4*)kg, vreg = *(const u32x4*)vg;
    const int NT = S / 64;
    float m_run = 0.f, l_run = 0.f;
    f32x16 negm;
#pragma unroll
    for (int r = 0; r < 16; ++r) negm[r] = 0.f;
    f32x16 o0, o1;
#pragma unroll
    for (int r = 0; r < 16; ++r) { o0[r] = 0.f; o1[r] = 0.f; }
    for (int t = 0; t < NT; ++t) {
        unsigned char* kb = lds + AT_K0 + (t & 1) * AT_KB; unsigned char* vb = lds + AT_V0 + (t & 1) * AT_KB;
        *(u32x4*)(kb + sr * 144 + sch * 16) = kreg;
        {
            bf16_t* vt = (bf16_t*)vb + (sch * 8) * 72 + vcol;
            vt[0 * 72] = (bf16_t)(vreg.x & 0xffffu); vt[1 * 72] = (bf16_t)(vreg.x >> 16); vt[2 * 72] = (bf16_t)(vreg.y & 0xffffu); vt[3 * 72] = (bf16_t)(vreg.y >> 16);
            vt[4 * 72] = (bf16_t)(vreg.z & 0xffffu); vt[5 * 72] = (bf16_t)(vreg.z >> 16); vt[6 * 72] = (bf16_t)(vreg.w & 0xffffu); vt[7 * 72] = (bf16_t)(vreg.w >> 16);
        }
        __syncthreads();
        if (t + 1 < NT) { kreg = *(const u32x4*)(kg + (size_t)(t + 1) * 64 * ldkv); vreg = *(const u32x4*)(vg + (size_t)(t + 1) * 64 * ldkv); }
        f32x16 p0, p1;
#pragma unroll
        for (int d0 = 0; d0 < DK / 16; ++d0) {
            const bf16x8 k0 = *(const bf16x8*)(kb + r32 * 144 + (kcsub + 16 * d0 + 8 * hi) * 2);
            const bf16x8 k1 = *(const bf16x8*)(kb + (32 + r32) * 144 + (kcsub + 16 * d0 + 8 * hi) * 2);
            if (d0 == 0) { p0 = __builtin_amdgcn_mfma_f32_32x32x16_bf16(k0, qf[0], negm, 0, 0, 0); p1 = __builtin_amdgcn_mfma_f32_32x32x16_bf16(k1, qf[0], negm, 0, 0, 0); }
            else { p0 = __builtin_amdgcn_mfma_f32_32x32x16_bf16(k0, qf[d0], p0, 0, 0, 0); p1 = __builtin_amdgcn_mfma_f32_32x32x16_bf16(k1, qf[d0], p1, 0, 0, 0); }
        }
        float mxa = fmaxf(fmaxf(p0[0], p0[1]), p1[0]), mxb = fmaxf(fmaxf(p0[2], p0[3]), p1[1]);
        mxa = fmaxf(fmaxf(mxa, p1[2]), p1[3]);
#pragma unroll
        for (int r = 4; r < 16; r += 4) { mxa = fmaxf(fmaxf(mxa, p0[r]), p0[r + 1]); mxb = fmaxf(fmaxf(mxb, p0[r + 2]), p0[r + 3]); mxa = fmaxf(fmaxf(mxa, p1[r]), p1[r + 1]); mxb = fmaxf(fmaxf(mxb, p1[r + 2]), p1[r + 3]); }
        float mx = fmaxf(mxa, mxb);
        if (__any(mx > 6.0f)) {
            mx = fmaxf(mx, __shfl_xor(mx, 32));
            const float dl = fmaxf(mx, 0.f); m_run += dl;
            const float alpha = __builtin_amdgcn_exp2f(-dl); l_run *= alpha;
#pragma unroll
            for (int r = 0; r < 16; ++r) { p0[r] -= dl; p1[r] -= dl; o0[r] *= alpha; o1[r] *= alpha; negm[r] = -m_run; }
        }
#pragma unroll
        for (int r = 0; r < 16; ++r) { p0[r] = __builtin_amdgcn_exp2f(p0[r]); p1[r] = __builtin_amdgcn_exp2f(p1[r]); }
        {
            typedef float f32x2 __attribute__((ext_vector_type(2)));
            f32x2 s2 = (f32x2){p0[0], p0[1]} + (f32x2){p1[0], p1[1]};
#pragma unroll
            for (int r = 2; r < 16; r += 2) { s2 += (f32x2){p0[r], p0[r + 1]}; s2 += (f32x2){p1[r], p1[r + 1]}; }
            l_run += s2[0] + s2[1];
        }
        bf16x8 pk[4];
#pragma unroll
        for (int ks = 0; ks < 4; ++ks) {
            u32x4 w;
            if (ks < 2) { w.x = pg8::cvt_pk_bf16(p0[8 * ks + 0], p0[8 * ks + 1]); w.y = pg8::cvt_pk_bf16(p0[8 * ks + 2], p0[8 * ks + 3]); w.z = pg8::cvt_pk_bf16(p0[8 * ks + 4], p0[8 * ks + 5]); w.w = pg8::cvt_pk_bf16(p0[8 * ks + 6], p0[8 * ks + 7]); }
            else { const int b = 8 * (ks - 2); w.x = pg8::cvt_pk_bf16(p1[b + 0], p1[b + 1]); w.y = pg8::cvt_pk_bf16(p1[b + 2], p1[b + 3]); w.z = pg8::cvt_pk_bf16(p1[b + 4], p1[b + 5]); w.w = pg8::cvt_pk_bf16(p1[b + 6], p1[b + 7]); }
            pk[ks] = __builtin_bit_cast(bf16x8, w);
        }
#pragma unroll
        for (int ks = 0; ks < 4; ++ks) {
            const bf16x8 v0 = *(const bf16x8*)(vb + r32 * 144 + (16 * ks + 8 * hi) * 2);
            const bf16x8 v1 = *(const bf16x8*)(vb + (32 + r32) * 144 + (16 * ks + 8 * hi) * 2);
            o0 = __builtin_amdgcn_mfma_f32_32x32x16_bf16(v0, pk[ks], o0, 0, 0, 0);
            o1 = __builtin_amdgcn_mfma_f32_32x32x16_bf16(v1, pk[ks], o1, 0, 0, 0);
        }
    }
    const float lt = l_run + __shfl_xor(l_run, 32); const float inv = 1.0f / lt;
#pragma unroll
    for (int r = 0; r < 16; ++r) { o0[r] *= inv; o1[r] *= inv; }
    bf16_t* CAT = (bf16_t*)(a.ws + WS_CAT);
    if (is_diff) {
        float* XCH = (float*)(lds + AT_XCH);
        if (sub == 1) {
#pragma unroll
            for (int r = 0; r < 16; ++r) { XCH[(wq * 32 + r) * 64 + lane] = o0[r]; XCH[(wq * 32 + 16 + r) * 64 + lane] = o1[r]; }
        }
        __syncthreads();
        if (sub == 0) {
            float d1 = (lane < 32) ? inptr(I_LQ1)[l * 32 + lane] * inptr(I_LK1)[l * 32 + lane] : 0.f;
            float d2 = (lane < 32) ? inptr(I_LQ2)[l * 32 + lane] * inptr(I_LK2)[l * 32 + lane] : 0.f;
            const float lam_init = (l == 0) ? 0.2f : 0.35550907f;
            const float lam = __expf(wave_sum(d1)) - __expf(wave_sum(d2)) + lam_init;
            float ss = 0.f;
#pragma unroll
            for (int r = 0; r < 16; ++r) { o0[r] -= lam * XCH[(wq * 32 + r) * 64 + lane]; o1[r] -= lam * XCH[(wq * 32 + 16 + r) * 64 + lane]; ss += o0[r] * o0[r] + o1[r] * o1[r]; }
            ss += __shfl_xor(ss, 32);
            const float rs = rsqrtf(ss * (1.0f / 64.0f) + EPS) * (1.0f - lam_init);
            bf16_t* op = CAT + (size_t)qrow * D + 256 + hidx * 64;
#pragma unroll
            for (int g = 0; g < 4; ++g) {
                const int d = 8 * g + 4 * hi; const float* sl = inptr(I_SUBLN) + l * 64;
                u32x2 w0, w1;
                w0.x = pk2(o0[4 * g + 0] * rs * sl[d + 0], o0[4 * g + 1] * rs * sl[d + 1]); w0.y = pk2(o0[4 * g + 2] * rs * sl[d + 2], o0[4 * g + 3] * rs * sl[d + 3]);
                w1.x = pk2(o1[4 * g + 0] * rs * sl[32 + d + 0], o1[4 * g + 1] * rs * sl[32 + d + 1]); w1.y = pk2(o1[4 * g + 2] * rs * sl[32 + d + 2], o1[4 * g + 3] * rs * sl[32 + d + 3]);
                *(u32x2*)(op + d) = w0; *(u32x2*)(op + 32 + d) = w1;
            }
        }
    } else {
        bf16_t* op = CAT + (size_t)qrow * D + 768 + (2 * hidx + sub) * 64;
#pragma unroll
        for (int g = 0; g < 4; ++g) {
            const int d = 8 * g + 4 * hi;
            u32x2 w0, w1;
            w0.x = pk2(o0[4 * g + 0], o0[4 * g + 1]); w0.y = pk2(o0[4 * g + 2], o0[4 * g + 3]);
            w1.x = pk2(o1[4 * g + 0], o1[4 * g + 1]); w1.y = pk2(o1[4 * g + 2], o1[4 * g + 3]);
            *(u32x2*)(op + d) = w0; *(u32x2*)(op + 32 + d) = w1;
        }
    }
    __syncthreads();
}

__device__ __forceinline__ void attn_phase(const Args& a, unsigned char* lds, int l, int rep) {
    unsigned* ctr = (unsigned*)(a.ws + WS_CTL) + 64 * (1 + l + 2 * rep);
    unsigned* slot = (unsigned*)(lds + 131072);
    for (;;) {
        __syncthreads();
        if (threadIdx.x == 0) *slot = atomicAdd(ctr, 1u);
        __syncthreads();
        const int u = (int)*slot;
        if (u >= 384) break;
        bool is_diff, lat; int seq, qb, hidx;
        if (u < 64) { lat = true; is_diff = false; seq = u / 32; const int rem = u % 32; qb = rem >> 1; hidx = rem & 1; }
        else if (u < 192) { const int v = u - 64; lat = true; is_diff = true; seq = v / 64; const int rem = v % 64; qb = rem >> 2; hidx = rem & 3; }
        else if (u < 256) { const int v = u - 192; lat = false; is_diff = false; seq = v >> 2; const int rem = v & 3; qb = rem >> 1; hidx = rem & 1; }
        else { const int v = u - 256; lat = false; is_diff = true; seq = v >> 3; const int rem = v & 7; qb = rem >> 2; hidx = rem & 3; }
        const int qrow0 = lat ? CTX_TOK + seq * SEQ_L + qb * 128 : seq * SEQ_C + qb * 128;
        const int S = lat ? S_LAT : SEQ_C;
        if (is_diff) {
            const bf16_t* Kp = lat ? (const bf16_t*)(a.ws + WS_KDL) + (size_t)seq * S_LAT * 256 : (const bf16_t*)(a.ws + WS_KDC) + (size_t)seq * SEQ_C * 256;
            const bf16_t* Vp = lat ? (const bf16_t*)(a.ws + WS_VDL) + (size_t)seq * S_LAT * 256 : (const bf16_t*)(a.ws + WS_VDC) + (size_t)seq * SEQ_C * 256;
            attn_unit<32>(lds, a, l, true, hidx, qrow0, Kp, Vp, 256, S);
        } else {
            const bf16_t* Kp = lat ? (const bf16_t*)(a.ws + WS_KGL) + (size_t)seq * S_LAT * 128 : (const bf16_t*)(a.ws + WS_KGC) + (size_t)seq * SEQ_C * 128;
            const bf16_t* Vp = lat ? (const bf16_t*)(a.ws + WS_VGL) + (size_t)seq * S_LAT * 128 : (const bf16_t*)(a.ws + WS_VGC) + (size_t)seq * SEQ_C * 128;
            attn_unit<64>(lds, a, l, false, hidx, qrow0, Kp, Vp, 128, S);
        }
    }
}

#define XB_TMO      128
#define XB_XCNT(j)  (256  + 64 * (j))
#define XB_XSUB(j)  (1280 + 64 * (j))
#define XB_XGEN(j)  (2304 + 64 * (j))
#define XB_TOP      3328
#define XB_TOPGEN   3392
#define XCD_BAR_WORDS 3456
#define XB_SPIN_CAP (1u << 18)
__device__ __forceinline__ unsigned xb_ld(unsigned* p)              { return __hip_atomic_load(p, __ATOMIC_RELAXED, __HIP_MEMORY_SCOPE_AGENT); }
__device__ __forceinline__ unsigned xb_add(unsigned* p, unsigned v) { return __hip_atomic_fetch_add(p, v, __ATOMIC_RELAXED, __HIP_MEMORY_SCOPE_AGENT); }
__device__ __forceinline__ unsigned xb_xcc_id() { return (unsigned)__builtin_amdgcn_s_getreg((3 << 11) | 20) & 0xFu; }
#define XB_SPIN(cond, bar) do { unsigned _sp = 0; while (cond) { __builtin_amdgcn_s_sleep(1); \
    if ((++_sp & 255u) == 0u) { if (xb_ld(&(bar)[XB_TMO])) break; if (_sp > XB_SPIN_CAP) { atomicAdd(&(bar)[XB_TMO], 1u); break; } } } } while (0)
struct XcdBarrier { unsigned* bar; unsigned x; volatile LAS unsigned* st; };
__device__ __forceinline__ XcdBarrier xcd_barrier_post(unsigned* bar, volatile LAS unsigned* st) {
    XcdBarrier b; b.bar = bar; b.x = xb_xcc_id(); b.st = st;
    if (threadIdx.x == 0) (void)xb_add(&bar[XB_XCNT(b.x)], 1u);
    return b;
}
__device__ __forceinline__ void xcd_barrier_complete(unsigned* bar, unsigned x, unsigned& nloc, unsigned& nx) {
    const unsigned G = gridDim.x * gridDim.y * gridDim.z;
    unsigned sum, cnt, mine, sp = 0u;
    for (;;) {
        sum = 0u; cnt = 0u; mine = 0u;
#pragma unroll 1
        for (unsigned j = 0; j < 16; ++j) { const unsigned c = xb_ld(&bar[XB_XCNT(j)]); sum += c; cnt += (c > 0u) ? 1u : 0u; mine = (j == x) ? c : mine; }
        if (sum == G) break;
        __builtin_amdgcn_s_sleep(1);
        if ((++sp & 255u) == 0u) { if (xb_ld(&bar[XB_TMO])) break; if (sp > XB_SPIN_CAP) { atomicAdd(&bar[XB_TMO], 1u); break; } }
    }
    nloc = mine > 0u ? mine : 1u; nx = cnt > 0u ? cnt : 1u;
}
__device__ __forceinline__ void xcd_barrier(const XcdBarrier& b) {
    asm volatile("s_waitcnt vmcnt(0)" ::: "memory");
    __syncthreads();
    if (threadIdx.x == 0) {
        unsigned* bar = b.bar;
        __builtin_amdgcn_s_waitcnt(0);
        unsigned nloc = b.st[0], nx = b.st[1];
        if (nloc == 0u) { xcd_barrier_complete(bar, b.x, nloc, nx); b.st[0] = nloc; b.st[1] = nx; }
        const unsigned old = xb_add(&bar[XB_XSUB(b.x)], 1u);
        const unsigned gen = old / nloc;
        if (old + 1u == (gen + 1u) * nloc) {
            __builtin_amdgcn_fence(__ATOMIC_RELEASE, "agent");
            asm volatile("s_waitcnt vmcnt(0)" ::: "memory");
            const unsigned og = xb_add(&bar[XB_TOP], 1u);
            const unsigned tg = og / nx;
            if (og + 1u == (tg + 1u) * nx) xb_add(&bar[XB_TOPGEN], 1u);
            else XB_SPIN(xb_ld(&bar[XB_TOPGEN]) == tg, bar);
            __builtin_amdgcn_fence(__ATOMIC_ACQUIRE, "agent");
            xb_add(&bar[XB_XGEN(b.x)], 1u);
            asm volatile("s_waitcnt vmcnt(0)" ::: "memory");
        } else {
            XB_SPIN(xb_ld(&bar[XB_XGEN(b.x)]) == gen, bar);
            __builtin_amdgcn_fence(__ATOMIC_ACQUIRE, "agent");
            asm volatile("s_waitcnt vmcnt(0)" ::: "memory");
        }
    }
    __syncthreads();
}

__global__ void __launch_bounds__(512, 2) fwd_kernel(Args a) {
    extern __shared__ __attribute__((aligned(16))) unsigned char lds[];
    cg::grid_group grid = cg::this_grid();
    const int G = gridDim.x, bx = blockIdx.x;
    const int vcu = (G % 8 == 0) ? (bx % 8) * (G / 8) + bx / 8 : bx;
    const int NGW = G * 8;
    LAS unsigned char* lds3 = (LAS unsigned char*)lds;
    int ph = 0;
    if (threadIdx.x < 16) ((LAS unsigned*)(lds3 + 131072 + 12288))[threadIdx.x] = 0u;
    __syncthreads();
    XcdBarrier bar = xcd_barrier_post((unsigned*)(a.ws + WS_CTL) + 1024, (volatile LAS unsigned*)(lds3 + 131072 + 12288));
    if (a.ph_hi == -12345) grid.sync();
#define RUN(k) (a.ph_lo <= (k) && (k) < a.ph_hi)
#define SEAM() do { if (a.ph_lo <= ph && ph + 1 < a.ph_hi) { for (int rp_ = 0; rp_ < NREP(1); ++rp_) xcd_barrier(bar); } ++ph; } while (0)
#define REP(k) _Pragma("unroll 1") for (int rp_ = 0; rp_ < NREP(k); ++rp_)

    if (RUN(ph)) { REP(2) p0_prologue(a, lds, vcu, NGW); }
    SEAM();
    if (RUN(ph)) mod_finalize(a, vcu, G);
    SEAM();
    for (int l = 0; l < 2; ++l) {
        unsigned char* wl = a.ws + WS_W + (size_t)l * WL;
        if (l == 0) { if (RUN(ph)) norm_phase(a, lds, vcu, NGW, true, false, 0, 0, true, 0, 0); SEAM(); }
        if (RUN(ph)) { pg8::Gemm g{(const bf16_t*)(a.ws + WS_H), (const bf16_t*)(wl + WO_GU1), D}; pg8::StaticOrder S; S.init(TOK, NGU, 1, G, bx, D);
            pg8::EpiSwiGLU E{(bf16_t*)(a.ws + WS_ACT)}; REP(5) pg8::gemm_phase(lds3, g, S, E); }
        SEAM();
        if (RUN(ph)) { pg8::Gemm g{(const bf16_t*)(a.ws + WS_ACT), (const bf16_t*)(wl + WO_D1), DFF}; pg8::StaticOrder S; S.init(TOK, D, 2, G, bx, DFF / 2);
            pg8::EpiBf16 E{(bf16_t*)(a.ws + WS_Y), D, (size_t)TOK * D}; REP(7) pg8::gemm_phase(lds3, g, S, E); }
        SEAM();
        if (RUN(ph)) { if (PROBE == 6) { for (int rp_ = 0; rp_ < 2; ++rp_) norm_phase(a, lds, vcu, NGW, false, true, l, 0, true, l, 1, true); } norm_phase(a, lds, vcu, NGW, l == 0, true, l, 0, true, l, 1); }
        SEAM();
        if (RUN(ph)) { pg8::Gemm g{(const bf16_t*)(a.ws + WS_H), (const bf16_t*)(wl + WO_MI), D}; pg8::MixInOrder S; S.init(G, bx);
            pg8::EpiMixIn E{(bf16_t*)(a.ws + WS_ACT), (bf16_t*)(a.ws + WS_Y)}; REP(8) pg8::gemm_phase(lds3, g, S, E); }
        SEAM();
        if (RUN(ph)) { REP(4) mix_prep(a, lds, l); }
        SEAM();
        if (RUN(ph)) { REP(3) attn_phase(a, lds, l, rp_); }
        SEAM();
        if (RUN(ph)) { pg8::Gemm g{(const bf16_t*)(a.ws + WS_CAT), (const bf16_t*)(wl + WO_MO), D}; pg8::StaticOrder S; S.init(TOK, D, 2, G, bx, D / 2);
            pg8::EpiBf16 E{(bf16_t*)(a.ws + WS_Y), D, (size_t)TOK * D}; REP(7) pg8::gemm_phase(lds3, g, S, E); }
        SEAM();
        if (RUN(ph)) norm_phase(a, lds, vcu, NGW, false, true, l, 1, true, l, 2);
        SEAM();
        if (RUN(ph)) { pg8::Gemm g{(const bf16_t*)(a.ws + WS_H), (const bf16_t*)(wl + WO_GU2), D}; pg8::StaticOrder S; S.init(TOK, NGU, 1, G, bx, D);
            pg8::EpiSwiGLU E{(bf16_t*)(a.ws + WS_ACT)}; REP(5) pg8::gemm_phase(lds3, g, S, E); }
        SEAM();
        if (RUN(ph)) { pg8::Gemm g{(const bf16_t*)(a.ws + WS_ACT), (const bf16_t*)(wl + WO_D2), DFF}; pg8::StaticOrder S; S.init(TOK, D, 2, G, bx, DFF / 2);
            pg8::EpiBf16 E{(bf16_t*)(a.ws + WS_Y), D, (size_t)TOK * D}; REP(7) pg8::gemm_phase(lds3, g, S, E); }
        SEAM();
        if (RUN(ph)) norm_phase(a, lds, vcu, NGW, false, true, l, 2, l == 0, 1, 0);
        SEAM();
    }
#undef RUN
#undef SEAM
}

extern "C" void kernel_launch(void* const* d_in, const int* in_sizes, int n_in, void* d_out, int out_size, void* d_ws, size_t ws_size, hipStream_t stream) {
    static int grid = 0;
    if (grid == 0) {
        if (n_in != 33 || ws_size < WS_END) { fprintf(stderr, "kernel_launch: unexpected n_in %d / ws_size %zu\n", n_in, ws_size); grid = -1; return; }
        int dev = 0, cus = 0, per_cu = 0;
        (void)hipGetDevice(&dev);
        (void)hipDeviceGetAttribute(&cus, hipDeviceAttributeMultiprocessorCount, dev);
        if (hipFuncSetAttribute((const void*)fwd_kernel, hipFuncAttributeMaxDynamicSharedMemorySize, LDS_BYTES) != hipSuccess) { fprintf(stderr, "kernel_launch: hipFuncSetAttribute failed\n"); grid = -1; return; }
        if (hipOccupancyMaxActiveBlocksPerMultiprocessor(&per_cu, (const void*)fwd_kernel, 512, LDS_BYTES) != hipSuccess || per_cu < 1) { fprintf(stderr, "kernel_launch: occupancy query gave %d\n", per_cu); per_cu = 1; }
        (void)hipGetLastError();
        grid = cus * 1;
    }
    if (grid < 0) return;
    (void)hipMemsetAsync((char*)d_ws + WS_CTL, 0, 65536, stream);
    Args a{};
    for (int i = 0; i < 33; ++i) a.in[i] = (const float*)d_in[i];
    a.out = (float*)d_out; a.ws = (unsigned char*)d_ws; a.ph_lo = 0; a.ph_hi = 1000;
    void* args[] = {&a};
    hipError_t e = hipLaunchCooperativeKernel((const void*)fwd_kernel, dim3(grid), dim3(512), args, LDS_BYTES, stream);
    if (e != hipSuccess) fprintf(stderr, "kernel_launch: cooperative launch failed: %s (grid %d)\n", hipGetErrorString(e), grid);
}
```

```cpp
#include <hip/hip_runtime.h>
#include <hip/hip_cooperative_groups.h>
#include <cstdio>
#include <cstdint>
namespace cg = cooperative_groups;
#ifndef PROBE
#define PROBE 0
#endif
#define NREP(k) ((PROBE == (k)) ? 3 : 1)

typedef unsigned short bf16_t;
typedef short bf16x8 __attribute__((ext_vector_type(8)));
typedef float f32x4 __attribute__((ext_vector_type(4)));
typedef float f32x16 __attribute__((ext_vector_type(16)));
typedef unsigned u32x4 __attribute__((ext_vector_type(4)));
typedef unsigned u32x2 __attribute__((ext_vector_type(2)));
#define LAS __attribute__((address_space(3)))

constexpr int D = 1024, TOK = 8192, CTX_TOK = 4096, DFF = 2816, NGU = 5632, MIXIN = 2560;
constexpr int SEQ_C = 256, SEQ_L = 2048, S_LAT = 2304, NMOD = 9216;
constexpr float EPS = 1e-6f;
constexpr float LOG2E = 1.4426950408889634f;

constexpr size_t MiB = 1u << 20;
constexpr size_t WS_CTL = 0;
constexpr size_t WS_MODP = 64 * 1024;
constexpr size_t WS_W = 2 * MiB, WL = 40 * MiB;
constexpr size_t WO_GU1 = 0, WO_D1 = 11 * MiB, WO_GU2 = 16 * MiB + 512 * 1024, WO_D2 = 27 * MiB + 512 * 1024, WO_MI = 33 * MiB, WO_MO = 38 * MiB;
constexpr size_t WS_H = 82 * MiB, WS_CAT = 98 * MiB, WS_ACT = 114 * MiB, WS_Y = 158 * MiB;
constexpr size_t WS_QD = 222 * MiB, WS_QG = 226 * MiB;
constexpr size_t WS_KDC = 230 * MiB, WS_VDC = 232 * MiB, WS_KGC = 234 * MiB, WS_VGC = 235 * MiB;
constexpr size_t WS_KDL = 236 * MiB, WS_VDL = 239 * MiB, WS_KGL = 242 * MiB, WS_VGL = 244 * MiB, WS_TAB = 246 * MiB, WS_END = 247 * MiB;

constexpr int LDS_BYTES = 131072 + 12288 + 64;

__device__ __forceinline__ float wave_sum(float v) {
#pragma unroll
    for (int o = 1; o < 64; o <<= 1) v += __shfl_xor(v, o);
    return v;
}
__device__ __forceinline__ unsigned f2bf(float f) { unsigned u = __builtin_bit_cast(unsigned, f); return (u + 0x7fffu + ((u >> 16) & 1u)) >> 16; }
typedef float f32x2_cv __attribute__((ext_vector_type(2))); typedef __bf16 bf16x2_cv __attribute__((ext_vector_type(2)));
__device__ __forceinline__ unsigned pk2(float lo, float hi) { f32x2_cv v = {lo, hi}; bf16x2_cv b = __builtin_convertvector(v, bf16x2_cv); return __builtin_bit_cast(unsigned, b); }
__device__ __forceinline__ float bf2f(bf16_t h) { return __builtin_bit_cast(float, (unsigned)h << 16); }
__device__ __forceinline__ float silu_f(float v) { return v * __builtin_amdgcn_rcpf(1.0f + __builtin_amdgcn_exp2f(-1.4426950408889634f * v)); }
__device__ __forceinline__ int tid_now() { int t = threadIdx.x; asm volatile("" : "+v"(t)); return t; }

namespace pg8 {
constexpr int BM = 256, BK = 64, HALF = 128, HTB = HALF * BK * 2, NXCD = 8, WGM = 8;
__host__ __device__ __forceinline__ int lds_byte(int r, int c) { const int st = (r >> 4) * 2 + (c >> 5), rr = r & 15, cc = c & 31, ob = rr * 64 + cc * 2; return st * 1024 + (ob ^ (((ob >> 9) & 1) << 5)); }
__host__ __device__ __forceinline__ void stage_rc(int b, int& R, int& C) { const int st = b / 1024, sb = b % 1024, swz = sb ^ (((sb >> 9) & 1) << 5); R = (st >> 1) * 16 + swz / 64; C = (st & 1) * 32 + (swz % 64) / 2; }
__host__ __device__ __forceinline__ int perm32(int rho) { const int n = rho >> 4, i = rho & 15; return 8 * (i >> 2) + 4 * n + (i & 3); }

struct Unit { int pm, pn, ks, nt, koff; };
struct Gemm { const bf16_t* A; const bf16_t* Bt; int ld; };

struct StaticOrder {
    int nM, nN, nNr, nwg, G, c, Kloop;
    __device__ void init(int M, int N, int KS, int G_, int c_, int Kloop_) { nM = M / BM; nNr = N / BM; nN = nNr * KS; nwg = nM * nN; G = G_; c = c_; Kloop = Kloop_; }
    __device__ bool next(int i, Unit& u) const {
        const long L = (long)i * G + c; if (L >= nwg) return false;
        int wgid = (int)L; { const int q = nwg / NXCD, r = nwg % NXCD, xcd = wgid % NXCD, off = wgid / NXCD; wgid = (xcd < r ? xcd * (q + 1) : r * (q + 1) + (xcd - r) * q) + off; }
        const int nig = WGM * nN, gid = wgid / nig, fm = gid * WGM, gsz = (nM - fm) < WGM ? (nM - fm) : WGM;
        u.pm = fm + ((wgid % nig) % gsz); const int pv = (wgid % nig) / gsz; u.pn = pv % nNr; u.ks = pv / nNr; u.nt = Kloop / BK; u.koff = u.ks * Kloop * 2; return true;
    }
};

struct MixInOrder {
    StaticOrder S8; int G, c;
    __device__ void init(int G_, int c_) { S8.init(TOK, 2048, 1, G_, c_, D); G = G_; c = c_; }
    __device__ bool next(int i, Unit& u) const {
        const long L = (long)i * G + c;
        if (L < 256) return S8.next(i, u);
        if (L >= 512) return false;
        const int idx = (int)L - 256, r = idx & 7; u.pm = idx >> 3; u.pn = 8 + (r & 1); u.ks = r >> 1; u.nt = 4; u.koff = u.ks * 512; return true;
    }
};

__device__ __forceinline__ unsigned cvt_pk_bf16(float lo, float hi) { f32x2_cv v = {lo, hi}; bf16x2_cv b = __builtin_convertvector(v, bf16x2_cv); return __builtin_bit_cast(unsigned, b); }

struct EpiBf16 {
    static constexpr bool PERM = true;
    bf16_t* O; int ldc; size_t ks_stride;
    __device__ __forceinline__ void operator()(const f32x4 (&acc)[2][2][4][2], const Unit& u, int wr, int wc, int fr, int fq) const {
        bf16_t* Ob = O + (size_t)u.ks * ks_stride;
        const int row0 = u.pm * BM + wr * 64 + fr; const int col0 = u.pn * BM + wc * 32 + 8 * fq;
#pragma unroll
        for (int ai = 0; ai < 2; ++ai)
#pragma unroll
            for (int m = 0; m < 4; ++m) { bf16_t* rowp = Ob + (size_t)(row0 + ai * HALF + m * 16) * ldc + col0;
#pragma unroll
                for (int bj = 0; bj < 2; ++bj) { const f32x4 v0 = acc[ai][bj][m][0], v1 = acc[ai][bj][m][1];
                    u32x4 w; w.x = cvt_pk_bf16(v0[0], v0[1]); w.y = cvt_pk_bf16(v0[2], v0[3]); w.z = cvt_pk_bf16(v1[0], v1[1]); w.w = cvt_pk_bf16(v1[2], v1[3]);
                    *(u32x4*)(rowp + bj * HALF) = w; } }
    }
};
struct EpiMixIn {
    static constexpr bool PERM = true;
    bf16_t* PROJ; bf16_t* PART;
    __device__ __forceinline__ void operator()(const f32x4 (&acc)[2][2][4][2], const Unit& u, int wr, int wc, int fr, int fq) const {
        const bool part = u.pn >= 8;
        bf16_t* Ob = part ? PART + (size_t)u.ks * TOK * 512 : PROJ; const int ldc = part ? 512 : MIXIN;
        const int row0 = u.pm * BM + wr * 64 + fr; const int col0 = (part ? u.pn - 8 : u.pn) * BM + wc * 32 + 8 * fq;
#pragma unroll
        for (int ai = 0; ai < 2; ++ai)
#pragma unroll
            for (int m = 0; m < 4; ++m) { bf16_t* rowp = Ob + (size_t)(row0 + ai * HALF + m * 16) * ldc + col0;
#pragma unroll
                for (int bj = 0; bj < 2; ++bj) { const f32x4 v0 = acc[ai][bj][m][0], v1 = acc[ai][bj][m][1];
                    u32x4 w; w.x = cvt_pk_bf16(v0[0], v0[1]); w.y = cvt_pk_bf16(v0[2], v0[3]); w.z = cvt_pk_bf16(v1[0], v1[1]); w.w = cvt_pk_bf16(v1[2], v1[3]);
                    *(u32x4*)(rowp + bj * HALF) = w; } }
    }
};
struct EpiSwiGLU {
    static constexpr bool PERM = true;
    bf16_t* O;
    __device__ __forceinline__ void operator()(const f32x4 (&acc)[2][2][4][2], const Unit& u, int wr, int wc, int fr, int fq) const {
        const int row0 = u.pm * BM + wr * 64 + fr; const int col0 = u.pn * HALF + wc * 32 + 8 * fq;
#pragma unroll
        for (int ai = 0; ai < 2; ++ai)
#pragma unroll
            for (int m = 0; m < 4; ++m) { bf16_t* rowp = O + (size_t)(row0 + ai * HALF + m * 16) * DFF + col0;
                const f32x4 g0 = acc[ai][0][m][0], g1 = acc[ai][0][m][1], u0 = acc[ai][1][m][0], u1 = acc[ai][1][m][1];
                float r[8];
#pragma unroll
                for (int i = 0; i < 4; ++i) { r[i] = silu_f(g0[i]) * u0[i]; r[4 + i] = silu_f(g1[i]) * u1[i]; }
                u32x4 w; w.x = cvt_pk_bf16(r[0], r[1]); w.y = cvt_pk_bf16(r[2], r[3]); w.z = cvt_pk_bf16(r[4], r[5]); w.w = cvt_pk_bf16(r[6], r[7]);
                *(u32x4*)rowp = w; }
    }
};
struct EpiF32 {
    static constexpr bool PERM = false;
    float* O; int ldc; size_t ks_stride;
    __device__ __forceinline__ void operator()(const f32x4 (&acc)[2][2][4][2], const Unit& u, int wr, int wc, int fr, int fq) const {
        float* base = O + (size_t)u.ks * ks_stride;
        const int row0 = u.pm * BM + wr * 64 + fr; const int col0 = u.pn * BM + wc * 32 + 4 * fq;
#pragma unroll
        for (int ai = 0; ai < 2; ++ai)
#pragma unroll
            for (int m = 0; m < 4; ++m) { float* rowp = base + (size_t)(row0 + ai * HALF + m * 16) * ldc + col0;
#pragma unroll
                for (int bj = 0; bj < 2; ++bj)
#pragma unroll
                    for (int n = 0; n < 2; ++n) *(f32x4*)(rowp + bj * HALF + n * 16) = acc[ai][bj][m][n]; }
    }
};

template <class Epi, class Sched>
__device__ __forceinline__ void gemm_phase(LAS unsigned char* lds, const Gemm g, const Sched& S, const Epi& E) {
    const int tid = tid_now(), wid = __builtin_amdgcn_readfirstlane(tid >> 6), lane = tid & 63, wr = wid >> 2, wc = wid & 3, fr = lane & 15, fq = lane >> 4;
    const int K = g.ld;
    unsigned voffA[2], voffB[2];
#pragma unroll
    for (int i = 0; i < 2; ++i) { int R, C; stage_rc(tid * 16 + i * 8192, R, C); const int Rb = Epi::PERM ? ((R & ~31) + perm32(R & 31)) : R;
        voffA[i] = (unsigned)(R * K + C) * 2u; voffB[i] = (unsigned)(Rb * K + C) * 2u; }
    const size_t kstep = (size_t)(BK * 2);
    const size_t hstep = (size_t)HALF * K * 2;
    const size_t tstep = 2 * hstep;
    const unsigned ldsw = (unsigned)wid * 1024u;
    const int aoff = lds_byte(wr * 64 + fr, fq * 8), boff = lds_byte(wc * 32 + fr, fq * 8);
#define PG8_SA(b, h) (((b) * 2 + (h)) * HTB)
#define PG8_SB(b, h) ((4 + (b) * 2 + (h)) * HTB)
#define PG8_STAGE(bufoff, gbase, voff) do { _Pragma("unroll") for (int _i = 0; _i < 2; ++_i) \
        __builtin_amdgcn_global_load_lds((const unsigned*)((const char*)(gbase) + (voff)[_i]), (LAS unsigned*)(lds + (bufoff) + ldsw + _i * 8192), 16, 0, 0); } while (0)
#define PG8_LDA(dst, b, h) do { _Pragma("unroll") for (int m = 0; m < 4; ++m) _Pragma("unroll") for (int k = 0; k < 2; ++k) dst[m][k] = *(const LAS bf16x8*)(lds + PG8_SA(b, h) + aoff + m * 2048 + k * 1024); } while (0)
#define PG8_LDB(dst, b, h) do { _Pragma("unroll") for (int n = 0; n < 2; ++n) _Pragma("unroll") for (int k = 0; k < 2; ++k) dst[n][k] = *(const LAS bf16x8*)(lds + PG8_SB(b, h) + boff + n * 2048 + k * 1024); } while (0)
#define PG8_MMA(ai, bj, At, Bt) do { __builtin_amdgcn_s_setprio(1); _Pragma("unroll") for (int m = 0; m < 4; ++m) _Pragma("unroll") for (int n = 0; n < 2; ++n) _Pragma("unroll") for (int k = 0; k < 2; ++k) \
        acc[ai][bj][m][n] = __builtin_amdgcn_mfma_f32_16x16x32_bf16(Bt[n][k], At[m][k], acc[ai][bj][m][n], 0, 0, 0); __builtin_amdgcn_s_setprio(0); } while (0)
#define PG8_WAIT_V(n) asm volatile("s_waitcnt vmcnt(" #n ")" ::: "memory")
#define PG8_WAIT_L(n) asm volatile("s_waitcnt lgkmcnt(" #n ")" ::: "memory")
#define PG8_BAR __builtin_amdgcn_s_barrier()
#define PG8_SCHED __builtin_amdgcn_sched_barrier(0)
    Unit cur, nxt; int ui = 0;
    if (!S.next(0, cur)) return;
    f32x4 acc[2][2][4][2];
#pragma unroll
    for (int a = 0; a < 2; ++a)
#pragma unroll
        for (int b = 0; b < 2; ++b)
#pragma unroll
            for (int m = 0; m < 4; ++m)
#pragma unroll
                for (int n = 0; n < 2; ++n) acc[a][b][m][n] = (f32x4){0.f, 0.f, 0.f, 0.f};
    bf16x8 At[4][2], B0[2][2], B1[2][2];
    const char* cA = (const char*)g.A + (size_t)cur.pm * tstep + (size_t)cur.koff; const char* cB = (const char*)g.Bt + (size_t)cur.pn * tstep + (size_t)cur.koff;
    PG8_STAGE(PG8_SB(0, 0), cB, voffB); PG8_STAGE(PG8_SB(0, 1), cB + hstep, voffB); PG8_STAGE(PG8_SA(0, 0), cA, voffA); PG8_STAGE(PG8_SA(0, 1), cA + hstep, voffA);
    if (wr == 1) PG8_BAR;
    PG8_WAIT_V(2); PG8_BAR;
    PG8_STAGE(PG8_SB(1, 0), cB + kstep, voffB); PG8_STAGE(PG8_SA(1, 0), cA + kstep, voffA); PG8_STAGE(PG8_SB(1, 1), cB + hstep + kstep, voffB);
    PG8_WAIT_V(6); PG8_BAR;
    for (;;) {
        const bool has_next = S.next(ui + 1, nxt);
        const char* nA = has_next ? (const char*)g.A + (size_t)nxt.pm * tstep + (size_t)nxt.koff : cA; const char* nB = has_next ? (const char*)g.Bt + (size_t)nxt.pn * tstep + (size_t)nxt.koff : cB;
        const int nt = cur.nt;
        for (int t = 0; t < nt; t += 2) {
            const bool last = (t == nt - 2);
            const char* a1 = cA + (size_t)(t + 1) * kstep;
            const char* a2 = last ? nA : cA + (size_t)(t + 2) * kstep; const char* b2 = last ? nB : cB + (size_t)(t + 2) * kstep;
            const char* a3 = a2 + kstep; const char* b3 = b2 + kstep;
            PG8_LDB(B0, 0, 0); PG8_LDB(B1, 0, 1); PG8_SCHED; PG8_LDA(At, 0, 0); PG8_STAGE(PG8_SA(1, 1), a1 + hstep, voffA);
            PG8_WAIT_V(8); PG8_WAIT_L(0); PG8_BAR; PG8_MMA(0, 0, At, B0); PG8_MMA(0, 1, At, B1); PG8_BAR; PG8_SCHED;
            PG8_LDA(At, 0, 1); PG8_STAGE(PG8_SB(0, 0), b2, voffB); PG8_STAGE(PG8_SB(0, 1), b2 + hstep, voffB); PG8_STAGE(PG8_SA(0, 0), a2, voffA);
            PG8_WAIT_V(8); PG8_WAIT_L(0); PG8_BAR; PG8_MMA(1, 0, At, B0); PG8_MMA(1, 1, At, B1); PG8_BAR; PG8_SCHED;
            PG8_LDB(B0, 1, 0); PG8_LDB(B1, 1, 1); PG8_SCHED; PG8_LDA(At, 1, 0); PG8_STAGE(PG8_SA(0, 1), a2 + hstep, voffA);
            PG8_WAIT_V(8); PG8_WAIT_L(0); PG8_BAR; PG8_MMA(0, 0, At, B0); PG8_MMA(0, 1, At, B1); PG8_BAR; PG8_SCHED;
            PG8_LDA(At, 1, 1); PG8_STAGE(PG8_SB(1, 0), b3, voffB); PG8_STAGE(PG8_SB(1, 1), b3 + hstep, voffB); PG8_STAGE(PG8_SA(1, 0), a3, voffA);
            PG8_WAIT_V(8); PG8_WAIT_L(0); PG8_BAR; PG8_MMA(1, 0, At, B0); PG8_MMA(1, 1, At, B1); PG8_BAR; PG8_SCHED;
        }
        if (wr == 0) PG8_BAR;
        E(acc, cur, wr, wc, fr, fq);
        if (!has_next) break;
#pragma unroll
        for (int a = 0; a < 2; ++a)
#pragma unroll
            for (int b = 0; b < 2; ++b)
#pragma unroll
                for (int m = 0; m < 4; ++m)
#pragma unroll
                    for (int n = 0; n < 2; ++n) acc[a][b][m][n] = (f32x4){0.f, 0.f, 0.f, 0.f};
        cur = nxt; cA = nA; cB = nB; ++ui;
        if (wr == 1) PG8_BAR;
    }
    PG8_WAIT_V(0);
    PG8_BAR;
#undef PG8_SA
#undef PG8_SB
#undef PG8_STAGE
#undef PG8_LDA
#undef PG8_LDB
#undef PG8_MMA
#undef PG8_WAIT_V
#undef PG8_WAIT_L
#undef PG8_BAR
#undef PG8_SCHED
}
}

struct Args { const float* in[33]; float* out; unsigned char* ws; int ph_lo, ph_hi; };
enum { I_XP = 0, I_XS, I_CDK, I_CDV, I_CGK, I_CGV, I_C, I_CCTX, I_WADA, I_BADA, I_NPRE, I_NPOST, I_F1G, I_F1U, I_F1D, I_F2G, I_F2U, I_F2D,
       I_WMI, I_WMO, I_SCW, I_LQ1, I_LK1, I_LQ2, I_LK2, I_SUBLN, I_CDWW, I_CDWB, I_CLNG, I_CLNB, I_CPW, I_QNORM, I_KNORM };

__device__ __forceinline__ const float* inptr(int i) {
    typedef const char __attribute__((address_space(4)))* kptr_t;
    kptr_t kp = (kptr_t)__builtin_amdgcn_kernarg_segment_ptr();
    unsigned off = 8u * (unsigned)i; asm volatile("" : "+s"(off));
    return *(const float* const __attribute__((address_space(4)))*)(kp + off);
}
__device__ __forceinline__ void tr_item(const float* W, int ldw, bf16_t* WT, int ldt, int k0, int n0, int orow0, float* scr, int lane) {
    f32x4 v[8];
    const int lr = lane >> 3, lc = (lane & 7) * 4;
#pragma unroll
    for (int i = 0; i < 8; ++i) v[i] = *(const f32x4*)(W + (size_t)(k0 + 8 * i + lr) * ldw + n0 + lc);
#pragma unroll
    for (int i = 0; i < 8; ++i) { float* d = scr + (8 * i + lr) * 33 + lc; d[0] = v[i][0]; d[1] = v[i][1]; d[2] = v[i][2]; d[3] = v[i][3]; }
    asm volatile("s_waitcnt lgkmcnt(0)" ::: "memory");
    const int c = lane & 7;
#pragma unroll
    for (int j = 0; j < 4; ++j) { const int n = (lane >> 3) + 8 * j; const float* s = scr + (8 * c) * 33 + n;
        u32x4 o; o.x = pk2(s[0 * 33], s[1 * 33]); o.y = pk2(s[2 * 33], s[3 * 33]); o.z = pk2(s[4 * 33], s[5 * 33]); o.w = pk2(s[6 * 33], s[7 * 33]);
        *(u32x4*)(WT + (size_t)(orow0 + n) * ldt + k0 + 8 * c) = o; }
    asm volatile("s_waitcnt lgkmcnt(0)" ::: "memory");
}

__device__ __forceinline__ void p0_prologue(const Args& a, unsigned char* lds, int vcu, int NGW) {
    const int tid = tid_now(), lane = tid & 63, wave = __builtin_amdgcn_readfirstlane(tid >> 6), gw = vcu * 8 + wave;
    float* SC = (float*)(lds + 131072);
    for (int i = tid; i < 3 * 1024; i += 512) { const int c = i >> 10, k = i & 1023; const float v = (c == 0) ? inptr(I_CCTX)[k] : inptr(I_C)[(c - 1) * 1024 + k]; SC[i] = silu_f(v); }
    __syncthreads();
    float* scr = (float*)(lds + wave * 16384);
    float* MODP = (float*)(a.ws + WS_MODP);
    constexpr int N_ADA = 2304, N_FOLD = 1024, N_TRL = 10112, N_TR = 2 * N_TRL, NIT = N_ADA + N_FOLD + N_TR;
    for (int it = gw; it < NIT; it += NGW) {
        if (it < N_ADA) {
            const int l = it / 1152, r2 = it % 1152, cb = r2 >> 3, kc = r2 & 7, col = cb * 64 + lane;
            const float* W = inptr(I_WADA) + (size_t)l * 1024 * NMOD + (size_t)(kc * 128) * NMOD + col;
            const float* s0 = SC + kc * 128;
            float a0 = 0.f, a1 = 0.f, a2 = 0.f;
#pragma unroll 32
            for (int k = 0; k < 128; ++k) { const float w = W[(size_t)k * NMOD]; a0 += s0[k] * w; a1 += s0[1024 + k] * w; a2 += s0[2048 + k] * w; }
            float* o = MODP + (size_t)((l * 8 + kc) * 3) * NMOD + col;
            o[0] = a0; o[NMOD] = a1; o[2 * NMOD] = a2;
        } else if (it < N_ADA + N_FOLD) {
            const int r = it - N_ADA, l = r >> 9, r2 = r & 511, kg = r2 >> 4, nb = r2 & 15, k0 = kg * 8, n = nb * 64 + lane;
            const float* pw = inptr(I_CPW) + (size_t)l * 65536 + (size_t)k0 * 256;
            const float* wm = inptr(I_WMO) + (size_t)l * 1048576 + (size_t)512 * 1024 + n;
            {
#pragma unroll
                for (int i = 0; i < 8; ++i) { const f32x4 pv = *(const f32x4*)(pw + i * 256 + 4 * lane);
                    scr[(4 * lane + 0) * 8 + i] = pv[0]; scr[(4 * lane + 1) * 8 + i] = pv[1]; scr[(4 * lane + 2) * 8 + i] = pv[2]; scr[(4 * lane + 3) * 8 + i] = pv[3]; }
                asm volatile("s_waitcnt lgkmcnt(0)" ::: "memory");
            }
            float acc[8];
#pragma unroll
            for (int q = 0; q < 8; ++q) acc[q] = 0.f;
#pragma unroll 32
            for (int j = 0; j < 256; ++j) { const float wv = wm[(size_t)j * 1024];
                const f32x4 pa = *(const f32x4*)(scr + j * 8), pb = *(const f32x4*)(scr + j * 8 + 4);
                acc[0] += pa[0] * wv; acc[1] += pa[1] * wv; acc[2] += pa[2] * wv; acc[3] += pa[3] * wv;
                acc[4] += pb[0] * wv; acc[5] += pb[1] * wv; acc[6] += pb[2] * wv; acc[7] += pb[3] * wv; }
            asm volatile("s_waitcnt lgkmcnt(0)" ::: "memory");
            bf16_t* WT = (bf16_t*)(a.ws + WS_W + l * WL + WO_MO);
            u32x4 o; o.x = pk2(acc[0], acc[1]); o.y = pk2(acc[2], acc[3]); o.z = pk2(acc[4], acc[5]); o.w = pk2(acc[6], acc[7]);
            *(u32x4*)(WT + (size_t)n * 1024 + 512 + k0) = o;
        } else {
            int r = it - N_ADA - N_FOLD; const int l = r / N_TRL; r %= N_TRL;
            unsigned char* wl = a.ws + WS_W + l * WL;
            if (r < 8448) {
                const int which = r / 1408, q = r % 1408;
                const int ffn = which / 3, kind = which % 3;
                const float* W = inptr((ffn ? I_F2G : I_F1G) + kind) + (size_t)l * 1024 * DFF;
                if (kind < 2) { const int kb = q / 88, nb = q % 88, n0 = nb * 32;
                    tr_item(W, DFF, (bf16_t*)(wl + (ffn ? WO_GU2 : WO_GU1)), 1024, kb * 64, n0, (n0 >> 7) * 256 + (n0 & 127) + kind * 128, scr, lane); }
                else { const int kb = q / 32, nb = q % 32;
                    tr_item(W, 1024, (bf16_t*)(wl + (ffn ? WO_D2 : WO_D1)), DFF, kb * 64, nb * 32, nb * 32, scr, lane); }
            } else if (r < 8448 + 1280) { const int q = r - 8448, kb = q / 80, nb = q % 80;
                tr_item(inptr(I_WMI) + (size_t)l * 1024 * MIXIN, MIXIN, (bf16_t*)(wl + WO_MI), 1024, kb * 64, nb * 32, nb * 32, scr, lane);
            } else { const int q = r - 9728, kbi = q / 32, nb = q % 32, kb = kbi < 8 ? kbi : kbi + 4;
                tr_item(inptr(I_WMO) + (size_t)l * 1048576, 1024, (bf16_t*)(wl + WO_MO), 1024, kb * 64, nb * 32, nb * 32, scr, lane);
            }
        }
    }
}

__device__ __forceinline__ void mod_finalize(const Args& a, int vcu, int G) {
    const int tid = tid_now();
    const float* MODP = (const float*)(a.ws + WS_MODP); float* TAB = (float*)(a.ws + WS_TAB);
    const float* bada = inptr(I_BADA); const float* npost = inptr(I_NPOST); const float* npre = inptr(I_NPRE);
    for (int idx = vcu * 512 + tid; idx < 2 * 27 * 1024; idx += G * 512) {
        const int j = idx & 1023; int t = idx >> 10; const int c = t % 3; t /= 3; const int kind = t % 3; t /= 3; const int i = t % 3, l = t / 3;
        const int mi = kind == 0 ? 3 * i + 2 : (kind == 1 ? 3 * i + 1 : 3 * i);
        float v = bada[(size_t)l * NMOD + mi * 1024 + j];
#pragma unroll
        for (int kc = 0; kc < 8; ++kc) v += MODP[(size_t)((l * 8 + kc) * 3 + c) * NMOD + mi * 1024 + j];
        const float gs = (i == 1) ? 1.0f : 0.5f;
        TAB[idx] = kind == 0 ? gs * v * npost[(l * 3 + i) * 1024 + j] : (kind == 1 ? (1.0f + v) * npre[(l * 3 + i) * 1024 + j] : v);
    }
}

__device__ __forceinline__ void norm_phase(const Args& a, unsigned char* lds, int vcu, int NGW,
                                           bool first, bool has_prev, int lp, int ip, bool has_next, int ln, int in_, bool dry = false) {
    const int tid = tid_now(), lane = tid & 63, wave = __builtin_amdgcn_readfirstlane(tid >> 6), gw = vcu * 8 + wave;
    float* MV = (float*)lds;
    const float* TAB = (const float*)(a.ws + WS_TAB);
    __syncthreads();
    for (int idx = tid * 4; idx < 9216; idx += 2048) {
        const int kind = idx / 3072, rem = idx % 3072;
        const int l = kind == 0 ? lp : ln, i = kind == 0 ? ip : in_;
        f32x4 v = (f32x4){0.f, 0.f, 0.f, 0.f};
        if (kind == 0 ? has_prev : has_next) v = *(const f32x4*)(TAB + (size_t)(((l * 3 + i) * 3 + kind) * 3) * 1024 + rem);
        *(f32x4*)(MV + idx) = v;
    }
    __syncthreads();
    float* X = a.out; float* XO = dry ? (float*)(a.ws + WS_ACT) : a.out;
    const bf16_t* Y0 = (const bf16_t*)(a.ws + WS_Y); const bf16_t* Y1 = Y0 + (size_t)TOK * D;
    bf16_t* H = (bf16_t*)(a.ws + (dry ? WS_CAT : WS_H));
    const float* xp = inptr(I_XP); const float* xsm = inptr(I_XS);
    constexpr int R = 4;
    const int co = 8 * lane;
    for (int r0 = gw; r0 < TOK; r0 += R * NGW) {
        f32x4 x[R][4]; u32x4 ya[R][2], yb[R][2];
#pragma unroll
        for (int rr = 0; rr < R; ++rr) { const int row = r0 + rr * NGW;
            if (row < TOK) {
                const float* xs = first ? (row < CTX_TOK ? xp + (size_t)row * D : xsm + (size_t)(row - CTX_TOK) * D) : X + (size_t)row * D;
#pragma unroll
                for (int j = 0; j < 2; ++j) { x[rr][2 * j] = *(const f32x4*)(xs + co + 512 * j); x[rr][2 * j + 1] = *(const f32x4*)(xs + co + 512 * j + 4); }
                if (has_prev) {
#pragma unroll
                    for (int j = 0; j < 2; ++j) { ya[rr][j] = *(const u32x4*)(Y0 + (size_t)row * D + co + 512 * j); yb[rr][j] = *(const u32x4*)(Y1 + (size_t)row * D + co + 512 * j); }
                }
            } }
#pragma unroll
        for (int rr = 0; rr < R; ++rr) { const int row = r0 + rr * NGW;
            if (row < TOK) {
                const int c = row < CTX_TOK ? 0 : (row < CTX_TOK + SEQ_L ? 1 : 2);
                if (has_prev) {
                    f32x4 y[4]; float s = 0.f;
#pragma unroll
                    for (int j = 0; j < 2; ++j) {
#pragma unroll
                        for (int q = 0; q < 4; ++q) { const unsigned wa = ya[rr][j][q], wb = yb[rr][j][q];
                            const float lo = __builtin_bit_cast(float, wa << 16) + __builtin_bit_cast(float, wb << 16);
                            const float hi = __builtin_bit_cast(float, wa & 0xffff0000u) + __builtin_bit_cast(float, wb & 0xffff0000u);
                            y[2 * j + (q >> 1)][2 * (q & 1)] = lo; y[2 * j + (q >> 1)][2 * (q & 1) + 1] = hi; s += lo * lo + hi * hi; } }
                    const float ry = rsqrtf(wave_sum(s) * (1.0f / D) + EPS);
#pragma unroll
                    for (int j = 0; j < 2; ++j)
#pragma unroll
                        for (int h2 = 0; h2 < 2; ++h2) { const f32x4 gp = *(const f32x4*)(MV + c * 1024 + co + 512 * j + 4 * h2); x[rr][2 * j + h2] = x[rr][2 * j + h2] + gp * y[2 * j + h2] * ry; }
                }
                if (has_prev) {
#pragma unroll
                    for (int j = 0; j < 2; ++j) { *(f32x4*)(XO + (size_t)row * D + co + 512 * j) = x[rr][2 * j]; *(f32x4*)(XO + (size_t)row * D + co + 512 * j + 4) = x[rr][2 * j + 1]; }
                }
                if (has_next) {
                    float s = 0.f;
#pragma unroll
                    for (int q = 0; q < 4; ++q) s += (x[rr][q][0] * x[rr][q][0] + x[rr][q][1] * x[rr][q][1]) + (x[rr][q][2] * x[rr][q][2] + x[rr][q][3] * x[rr][q][3]);
                    const float rx = rsqrtf(wave_sum(s) * (1.0f / D) + EPS);
#pragma unroll
                    for (int j = 0; j < 2; ++j) {
                        const f32x4 a0 = *(const f32x4*)(MV + 3072 + c * 1024 + co + 512 * j), a1 = *(const f32x4*)(MV + 3072 + c * 1024 + co + 512 * j + 4);
                        const f32x4 s0 = *(const f32x4*)(MV + 6144 + c * 1024 + co + 512 * j), s1 = *(const f32x4*)(MV + 6144 + c * 1024 + co + 512 * j + 4);
                        const f32x4 h0 = x[rr][2 * j] * rx * a0 + s0, h1 = x[rr][2 * j + 1] * rx * a1 + s1;
                        u32x4 w; w.x = pg8::cvt_pk_bf16(h0[0], h0[1]); w.y = pg8::cvt_pk_bf16(h0[2], h0[3]); w.z = pg8::cvt_pk_bf16(h1[0], h1[1]); w.w = pg8::cvt_pk_bf16(h1[2], h1[3]);
                        *(u32x4*)(H + (size_t)row * D + co + 512 * j) = w; }
                }
            } }
    }
}

__device__ __forceinline__ void rope_pair(float& x, float xp, float ang, bool second) {
    const float s = __sinf(ang), c = __cosf(ang);
    x = second ? (xp * s + x * c) : (x * c - xp * s);
}
__device__ __forceinline__ float bflo(unsigned w) { return __builtin_bit_cast(float, w << 16); }
__device__ __forceinline__ float bfhi(unsigned w) { return __builtin_bit_cast(float, w & 0xffff0000u); }
__device__ __forceinline__ void mix_prep(const Args& a, unsigned char* lds, int l) {
    const int tid = tid_now(), lane = tid & 63, wave = __builtin_amdgcn_readfirstlane(tid >> 6);
    const bf16_t* PROJ = (const bf16_t*)(a.ws + WS_ACT);
    bf16_t* CAT = (bf16_t*)(a.ws + WS_CAT);
    bf16_t* QD = (bf16_t*)(a.ws + WS_QD); bf16_t* QG = (bf16_t*)(a.ws + WS_QG);
    float* U = (float*)lds;
    float* VB = (float*)(lds + 65536);
    const float qs_d = 0.17677669529663687f * LOG2E, qs_g = 0.125f * LOG2E;
    const float L2T = 13.287712379549449f;
    float invd[4], invg[4], invk[2];
#pragma unroll
    for (int t = 0; t < 4; ++t) { invd[t] = exp2f(-(float)(4 * (lane & 1) + t) * (L2T / 8.0f)); invg[t] = exp2f(-(float)(4 * (lane & 3) + t) * (L2T / 16.0f)); }
#pragma unroll
    for (int t = 0; t < 2; ++t) invk[t] = exp2f(-(float)(2 * (lane & 7) + t) * (L2T / 16.0f));
    for (int tile = blockIdx.x; tile < TOK / 32; tile += gridDim.x) {
        const int row0 = tile * 32; const bool lat = row0 >= CTX_TOK;
        int seq, pos0, seqlen;
        if (!lat) { seq = row0 / SEQ_C; pos0 = row0 % SEQ_C; seqlen = SEQ_C; } else { seq = (row0 - CTX_TOK) / SEQ_L; pos0 = (row0 - CTX_TOK) % SEQ_L; seqlen = SEQ_L; }
        bf16_t* KD = lat ? (bf16_t*)(a.ws + WS_KDL) + (size_t)(seq * S_LAT + 256) * 256 : (bf16_t*)(a.ws + WS_KDC) + (size_t)(seq * SEQ_C) * 256;
        bf16_t* VD = lat ? (bf16_t*)(a.ws + WS_VDL) + (size_t)(seq * S_LAT + 256) * 256 : (bf16_t*)(a.ws + WS_VDC) + (size_t)(seq * SEQ_C) * 256;
        bf16_t* KG = lat ? (bf16_t*)(a.ws + WS_KGL) + (size_t)(seq * S_LAT + 256) * 128 : (bf16_t*)(a.ws + WS_KGC) + (size_t)(seq * SEQ_C) * 128;
        bf16_t* VG = lat ? (bf16_t*)(a.ws + WS_VGL) + (size_t)(seq * S_LAT + 256) * 128 : (bf16_t*)(a.ws + WS_VGC) + (size_t)(seq * SEQ_C) * 128;
#pragma unroll 1
        for (int hh = 0; hh < 1; ++hh) {
            const int row_b = row0 + wave * 4, pos_b = pos0 + wave * 4;
            u32x2 dq[4], dk[4], dv[4], gqp[4][4], ab[4], ac[6], ah[6]; unsigned gkp[4][4], gvp[4][4];
#pragma unroll
            for (int rr = 0; rr < 4; ++rr) { const bf16_t* pr = PROJ + (size_t)(row_b + rr) * MIXIN;
                dq[rr] = *(const u32x2*)(pr + 768 + 4 * lane); dk[rr] = *(const u32x2*)(pr + 1024 + 4 * lane); dv[rr] = *(const u32x2*)(pr + 1280 + 4 * lane);
                ab[rr] = *(const u32x2*)(pr + 4 * lane); }
#pragma unroll
            for (int t = 0; t < 6; ++t) { const int tp = pos_b - 1 + t; const bool valid = tp >= 0 && tp < seqlen; const bf16_t* pr = PROJ + (size_t)(row_b - 1 + t) * MIXIN;
                ac[t] = (u32x2){0u, 0u}; ah[t] = (u32x2){0u, 0u};
                if (valid) { ac[t] = *(const u32x2*)(pr + 256 + 4 * lane); ah[t] = *(const u32x2*)(pr + 512 + 4 * lane); } }
#pragma unroll
            for (int rr = 0; rr < 4; ++rr) { const int row = row_b + rr, pos = pos_b + rr;
                float q[4] = {bflo(dq[rr].x), bfhi(dq[rr].x), bflo(dq[rr].y), bfhi(dq[rr].y)};
                float k[4] = {bflo(dk[rr].x), bfhi(dk[rr].x), bflo(dk[rr].y), bfhi(dk[rr].y)};
                if (lat) {
                    const float pax = (float)((lane & 4) ? (pos & 63) : (pos >> 6)); const bool second = (lane & 2) != 0;
#pragma unroll
                    for (int t = 0; t < 4; ++t) { const float ang = pax * invd[t]; const float sn = __sinf(ang), cs = __cosf(ang);
                        const float qp = __shfl_xor(q[t], 2), kp = __shfl_xor(k[t], 2);
                        q[t] = second ? (qp * sn + q[t] * cs) : (q[t] * cs - qp * sn); k[t] = second ? (kp * sn + k[t] * cs) : (k[t] * cs - kp * sn); }
                } else {
                    float* odk = a.out + 8388608 + ((size_t)(seq * 2 + l) * 256 + pos) * 256 + 4 * lane;
                    float* odv = a.out + 10485760 + ((size_t)(seq * 2 + l) * 256 + pos) * 256 + 4 * lane;
                    *(f32x4*)odk = (f32x4){k[0], k[1], k[2], k[3]};
                    *(f32x4*)odv = (f32x4){bflo(dv[rr].x), bfhi(dv[rr].x), bflo(dv[rr].y), bfhi(dv[rr].y)};
                }
                u32x2 w; w.x = pg8::cvt_pk_bf16(q[0] * qs_d, q[1] * qs_d); w.y = pg8::cvt_pk_bf16(q[2] * qs_d, q[3] * qs_d);
                *(u32x2*)(QD + (size_t)row * 256 + 4 * lane) = w;
                w.x = pg8::cvt_pk_bf16(k[0], k[1]); w.y = pg8::cvt_pk_bf16(k[2], k[3]);
                *(u32x2*)(KD + (size_t)pos * 256 + 4 * lane) = w;
                *(u32x2*)(VD + (size_t)pos * 256 + 4 * lane) = dv[rr];
            }
            {
                f32x4 scw[3];
#pragma unroll
                for (int k = 0; k < 3; ++k) scw[k] = *(const f32x4*)(inptr(I_SCW) + (l * 3 + k) * 256 + 4 * lane);
                float pr6[6][4];
#pragma unroll
                for (int t = 0; t < 6; ++t) { pr6[t][0] = bflo(ac[t].x) * bflo(ah[t].x); pr6[t][1] = bfhi(ac[t].x) * bfhi(ah[t].x); pr6[t][2] = bflo(ac[t].y) * bflo(ah[t].y); pr6[t][3] = bfhi(ac[t].y) * bfhi(ah[t].y); }
#pragma unroll
                for (int rr = 0; rr < 4; ++rr) {
                    float o[4]; const float b4[4] = {bflo(ab[rr].x), bfhi(ab[rr].x), bflo(ab[rr].y), bfhi(ab[rr].y)};
#pragma unroll
                    for (int e = 0; e < 4; ++e) o[e] = b4[e] * (scw[0][e] * pr6[rr][e] + scw[1][e] * pr6[rr + 1][e] + scw[2][e] * pr6[rr + 2][e]);
                    u32x2 w; w.x = pg8::cvt_pk_bf16(o[0], o[1]); w.y = pg8::cvt_pk_bf16(o[2], o[3]);
                    *(u32x2*)(CAT + (size_t)(row_b + rr) * D + 4 * lane) = w;
                }
            }
            asm volatile("" ::: "memory");
            const bf16_t* PART = (const bf16_t*)(a.ws + WS_Y);
#pragma unroll
            for (int rr = 0; rr < 4; ++rr)
#pragma unroll
                for (int ks = 0; ks < 4; ++ks) { const bf16_t* pp = PART + ((size_t)ks * TOK + row_b + rr) * 512;
                    gqp[rr][ks] = *(const u32x2*)(pp + 4 * lane); gkp[rr][ks] = *(const unsigned*)(pp + 256 + 2 * lane); gvp[rr][ks] = *(const unsigned*)(pp + 384 + 2 * lane); }
            const f32x4 qnv = *(const f32x4*)(inptr(I_QNORM) + l * 64 + 4 * (lane & 15));
#pragma unroll
            for (int rr = 0; rr < 4; ++rr) { const int row = row_b + rr, pos = pos_b + rr;
                float q[4] = {0.f, 0.f, 0.f, 0.f};
#pragma unroll
                for (int ks = 0; ks < 4; ++ks) { q[0] += bflo(gqp[rr][ks].x); q[1] += bfhi(gqp[rr][ks].x); q[2] += bflo(gqp[rr][ks].y); q[3] += bfhi(gqp[rr][ks].y); }
                float ss = (q[0] * q[0] + q[1] * q[1]) + (q[2] * q[2] + q[3] * q[3]);
                ss += __shfl_xor(ss, 1); ss += __shfl_xor(ss, 2); ss += __shfl_xor(ss, 4); ss += __shfl_xor(ss, 8);
                const float rn = rsqrtf(ss * (1.0f / 64.0f) + EPS);
#pragma unroll
                for (int t = 0; t < 4; ++t) q[t] = q[t] * rn * qnv[t];
                if (lat) {
                    const float pax = (float)((lane & 8) ? (pos & 63) : (pos >> 6)); const bool second = (lane & 4) != 0;
#pragma unroll
                    for (int t = 0; t < 4; ++t) { const float ang = pax * invg[t]; const float sn = __sinf(ang), cs = __cosf(ang);
                        const float qp = __shfl_xor(q[t], 4);
                        q[t] = second ? (qp * sn + q[t] * cs) : (q[t] * cs - qp * sn); }
                }
                u32x2 w; w.x = pg8::cvt_pk_bf16(q[0] * qs_g, q[1] * qs_g); w.y = pg8::cvt_pk_bf16(q[2] * qs_g, q[3] * qs_g);
                *(u32x2*)(QG + (size_t)row * 256 + 4 * lane) = w;
            }
            const float kn0 = inptr(I_KNORM)[l * 64 + 2 * (lane & 31)], kn1 = inptr(I_KNORM)[l * 64 + 2 * (lane & 31) + 1];
#pragma unroll
            for (int rr = 0; rr < 4; ++rr) { const int pos = pos_b + rr;
                float k0 = 0.f, k1 = 0.f, v0 = 0.f, v1 = 0.f;
#pragma unroll
                for (int ks = 0; ks < 4; ++ks) { k0 += bflo(gkp[rr][ks]); k1 += bfhi(gkp[rr][ks]); v0 += bflo(gvp[rr][ks]); v1 += bfhi(gvp[rr][ks]); }
                const unsigned vpk = pg8::cvt_pk_bf16(v0, v1);
                float ss = k0 * k0 + k1 * k1;
                ss += __shfl_xor(ss, 1); ss += __shfl_xor(ss, 2); ss += __shfl_xor(ss, 4); ss += __shfl_xor(ss, 8); ss += __shfl_xor(ss, 16);
                const float rn = rsqrtf(ss * (1.0f / 64.0f) + EPS);
                k0 = k0 * rn * kn0; k1 = k1 * rn * kn1;
                if (lat) {
                    const float pax = (float)((lane & 16) ? (pos & 63) : (pos >> 6)); const bool second = (lane & 8) != 0;
                    const float a0 = pax * invk[0], a1 = pax * invk[1];
                    const float s0 = __sinf(a0), c0 = __cosf(a0), s1 = __sinf(a1), c1 = __cosf(a1);
                    const float p0 = __shfl_xor(k0, 8), p1 = __shfl_xor(k1, 8);
                    k0 = second ? (p0 * s0 + k0 * c0) : (k0 * c0 - p0 * s0); k1 = second ? (p1 * s1 + k1 * c1) : (k1 * c1 - p1 * s1);
                } else {
                    float* ogk = a.out + 12582912 + ((size_t)(seq * 2 + l) * 256 + pos) * 128 + 2 * lane;
                    float* ogv = a.out + 13631488 + ((size_t)(seq * 2 + l) * 256 + pos) * 128 + 2 * lane;
                    typedef float f32x2 __attribute__((ext_vector_type(2)));
                    *(f32x2*)ogk = (f32x2){k0, k1}; *(f32x2*)ogv = (f32x2){bflo(vpk), bfhi(vpk)};
                }
                *(unsigned*)(KG + (size_t)pos * 128 + 2 * lane) = pg8::cvt_pk_bf16(k0, k1);
                *(unsigned*)(VG + (size_t)pos * 128 + 2 * lane) = vpk;
            }
        }
        if (wave < 2) {
            const int id = tile * 2 + wave, b = id >> 8, p = id & 255;
            const size_t src = ((size_t)(b * 2 + l) * 256 + p);
            typedef float f32x2 __attribute__((ext_vector_type(2)));
            const f32x4 ck = *(const f32x4*)(inptr(I_CDK) + src * 256 + 4 * lane), cv = *(const f32x4*)(inptr(I_CDV) + src * 256 + 4 * lane);
            const f32x2 gkk = *(const f32x2*)(inptr(I_CGK) + src * 128 + 2 * lane), gvv = *(const f32x2*)(inptr(I_CGV) + src * 128 + 2 * lane);
            u32x2 w; w.x = pg8::cvt_pk_bf16(ck[0], ck[1]); w.y = pg8::cvt_pk_bf16(ck[2], ck[3]);
            *(u32x2*)((bf16_t*)(a.ws + WS_KDL) + (size_t)(b * S_LAT + p) * 256 + 4 * lane) = w;
            w.x = pg8::cvt_pk_bf16(cv[0], cv[1]); w.y = pg8::cvt_pk_bf16(cv[2], cv[3]);
            *(u32x2*)((bf16_t*)(a.ws + WS_VDL) + (size_t)(b * S_LAT + p) * 256 + 4 * lane) = w;
            *(unsigned*)((bf16_t*)(a.ws + WS_KGL) + (size_t)(b * S_LAT + p) * 128 + 2 * lane) = pg8::cvt_pk_bf16(gkk[0], gkk[1]);
            *(unsigned*)((bf16_t*)(a.ws + WS_VGL) + (size_t)(b * S_LAT + p) * 128 + 2 * lane) = pg8::cvt_pk_bf16(gvv[0], gvv[1]);
        }
        __syncthreads();
        {
            const int cp = tid & 127, rg = tid >> 7;
            unsigned ca[16], cgv[16];
#pragma unroll
            for (int i = 0; i < 16; ++i) { const int r = rg + 4 * i, tp = pos0 - 15 + r; ca[i] = 0u; cgv[i] = 0u;
                if (r < 62 && tp >= 0 && tp < seqlen) { const bf16_t* p2 = PROJ + (size_t)(row0 - 15 + r) * MIXIN; ca[i] = *(const unsigned*)(p2 + 1536 + 2 * cp); cgv[i] = *(const unsigned*)(p2 + 1792 + 2 * cp); } }
#pragma unroll
            for (int i = 0; i < 16; ++i) { const int r = rg + 4 * i;
                if (r < 62) { typedef float f32x2 __attribute__((ext_vector_type(2)));
                    const float u0 = bflo(ca[i]) * __builtin_amdgcn_rcpf(1.0f + __builtin_amdgcn_exp2f(-LOG2E * bflo(cgv[i]))), u1 = bfhi(ca[i]) * __builtin_amdgcn_rcpf(1.0f + __builtin_amdgcn_exp2f(-LOG2E * bfhi(cgv[i])));
                    *(f32x2*)(U + r * 256 + 2 * cp) = (f32x2){u0, u1}; } }
        }
        __syncthreads();
        {
            const int c = tid & 255, half = tid >> 8;
            float w[31], acc[16];
#pragma unroll
            for (int k = 0; k < 31; ++k) w[k] = inptr(I_CDWW)[(l * 31 + k) * 256 + c];
            const float bias = inptr(I_CDWB)[l * 256 + c];
#pragma unroll
            for (int o = 0; o < 16; ++o) acc[o] = bias;
#pragma unroll
            for (int i = 0; i < 46; ++i) { const float u = U[(16 * half + i) * 256 + c];
#pragma unroll
                for (int o = 0; o < 16; ++o) { const int k = i - o; if (k >= 0 && k < 31) acc[o] += w[k] * u; } }
#pragma unroll
            for (int o = 0; o < 16; ++o) VB[(16 * half + o) * 256 + c] = acc[o];
        }
        __syncthreads();
        const f32x4 lng = *(const f32x4*)(inptr(I_CLNG) + l * 256 + 4 * lane), lnb = *(const f32x4*)(inptr(I_CLNB) + l * 256 + 4 * lane);
#pragma unroll
        for (int rr = 0; rr < 4; ++rr) {
            const int rl = wave * 4 + rr, row = row0 + rl;
            f32x4 v = *(const f32x4*)(VB + rl * 256 + 4 * lane);
            const float mu = wave_sum((v[0] + v[1]) + (v[2] + v[3])) * (1.0f / 256.0f);
            v = v - mu;
            const float rstd = rsqrtf(wave_sum((v[0] * v[0] + v[1] * v[1]) + (v[2] * v[2] + v[3] * v[3])) * (1.0f / 256.0f) + EPS);
            const f32x4 y = v * rstd * lng + lnb;
            u32x2 w; w.x = pg8::cvt_pk_bf16(silu_f(y[0]), silu_f(y[1])); w.y = pg8::cvt_pk_bf16(silu_f(y[2]), silu_f(y[3]));
            *(u32x2*)(CAT + (size_t)row * D + 512 + 4 * lane) = w;
        }
        __syncthreads();
    }
}

constexpr int AT_KB = 64 * 144;
constexpr int AT_K0 = 0, AT_V0 = 2 * AT_KB, AT_XCH = 40960;
template <int DK>
__device__ __forceinline__ void attn_unit(unsigned char* lds, const Args& a, int l, bool is_diff, int hidx, int qrow0, const bf16_t* Kp, const bf16_t* Vp, int ldkv, int S) {
    const int tid = tid_now(), lane = tid & 63, wave = __builtin_amdgcn_readfirstlane(tid >> 6), sub = wave >> 2, wq = wave & 3, r32 = lane & 31, hi = lane >> 5;
    const int kcol = hidx * 64;
    const int kcsub = is_diff ? sub * 32 : 0;
    const bf16_t* Qp = is_diff ? (const bf16_t*)(a.ws + WS_QD) + hidx * 64 + sub * 32 : (const bf16_t*)(a.ws + WS_QG) + (2 * hidx + sub) * 64;
    const int qrow = qrow0 + wq * 32 + r32;
    bf16x8 qf[DK / 16];
#pragma unroll
    for (int d0 = 0; d0 < DK / 16; ++d0) qf[d0] = *(const bf16x8*)(Qp + (size_t)qrow * 256 + d0 * 16 + hi * 8);
    const int sr = tid & 63, sch = tid >> 6;
    const bf16_t* kg = Kp + (size_t)sr * ldkv + kcol + sch * 8; const bf16_t* vg = Vp + (size_t)sr * ldkv + kcol + sch * 8;
    const int o16 = sr & 15; const int vcol = 16 * (sr >> 4) + 8 * ((o16 >> 2) & 1) + (o16 & 3) + 4 * (o16 >> 3);
    u32x4 kreg = *(const u32x4*)kg, vreg = *(const u32x4*)vg;
    const int NT = S / 64;
    float m_run = 0.f, l_run = 0.f;
    f32x16 negm;
#pragma unroll
    for (int r = 0; r < 16; ++r) negm[r] = 0.f;
    f32x16 o0, o1;
#pragma unroll
    for (int r = 0; r < 16; ++r) { o0[r] = 0.f; o1[r] = 0.f; }
    for (int t = 0; t < NT; ++t) {
        unsigned char* kb = lds + AT_K0 + (t & 1) * AT_KB; unsigned char* vb = lds + AT_V0 + (t & 1) * AT_KB;
        *(u32x4*)(kb + sr * 144 + sch * 16) = kreg;
        {
            bf16_t* vt = (bf16_t*)vb + (sch * 8) * 72 + vcol;
            vt[0 * 72] = (bf16_t)(vreg.x & 0xffffu); vt[1 * 72] = (bf16_t)(vreg.x >> 16); vt[2 * 72] = (bf16_t)(vreg.y & 0xffffu); vt[3 * 72] = (bf16_t)(vreg.y >> 16);
            vt[4 * 72] = (bf16_t)(vreg.z & 0xffffu); vt[5 * 72] = (bf16_t)(vreg.z >> 16); vt[6 * 72] = (bf16_t)(vreg.w & 0xffffu); vt[7 * 72] = (bf16_t)(vreg.w >> 16);
        }
        __syncthreads();
        if (t + 1 < NT) { kreg = *(const u32x4*)(kg + (size_t)(t + 1) * 64 * ldkv); vreg = *(const u32x4*)(vg + (size_t)(t + 1) * 64 * ldkv); }
        f32x16 p0, p1;
#pragma unroll
        for (int d0 = 0; d0 < DK / 16; ++d0) {
            const bf16x8 k0 = *(const bf16x8*)(kb + r32 * 144 + (kcsub + 16 * d0 + 8 * hi) * 2);
            const bf16x8 k1 = *(const bf16x8*)(kb + (32 + r32) * 144 + (kcsub + 16 * d0 + 8 * hi) * 2);
            if (d0 == 0) { p0 = __builtin_amdgcn_mfma_f32_32x32x16_bf16(k0, qf[0], negm, 0, 0, 0); p1 = __builtin_amdgcn_mfma_f32_32x32x16_bf16(k1, qf[0], negm, 0, 0, 0); }
            else { p0 = __builtin_amdgcn_mfma_f32_32x32x16_bf16(k0, qf[d0], p0, 0, 0, 0); p1 = __builtin_amdgcn_mfma_f32_32x32x16_bf16(k1, qf[d0], p1, 0, 0, 0); }
        }
        float mxa = fmaxf(fmaxf(p0[0], p0[1]), p1[0]), mxb = fmaxf(fmaxf(p0[2], p0[3]), p1[1]);
        mxa = fmaxf(fmaxf(mxa, p1[2]), p1[3]);
#pragma unroll
        for (int r = 4; r < 16; r += 4) { mxa = fmaxf(fmaxf(mxa, p0[r]), p0[r + 1]); mxb = fmaxf(fmaxf(mxb, p0[r + 2]), p0[r + 3]); mxa = fmaxf(fmaxf(mxa, p1[r]), p1[r + 1]); mxb = fmaxf(fmaxf(mxb, p1[r + 2]), p1[r + 3]); }
        float mx = fmaxf(mxa, mxb);
        if (__any(mx > 6.0f)) {
            mx = fmaxf(mx, __shfl_xor(mx, 32));
            const float dl = fmaxf(mx, 0.f); m_run += dl;
            const float alpha = __builtin_amdgcn_exp2f(-dl); l_run *= alpha;
#pragma unroll
            for (int r = 0; r < 16; ++r) { p0[r] -= dl; p1[r] -= dl; o0[r] *= alpha; o1[r] *= alpha; negm[r] = -m_run; }
        }
#pragma unroll
        for (int r = 0; r < 16; ++r) { p0[r] = __builtin_amdgcn_exp2f(p0[r]); p1[r] = __builtin_amdgcn_exp2f(p1[r]); }
        {
            typedef float f32x2 __attribute__((ext_vector_type(2)));
            f32x2 s2 = (f32x2){p0[0], p0[1]} + (f32x2){p1[0], p1[1]};
#pragma unroll
            for (int r = 2; r < 16; r += 2) { s2 += (f32x2){p0[r], p0[r + 1]}; s2 += (f32x2){p1[r], p1[r + 1]}; }
            l_run += s2[0] + s2[1];
        }
        bf16x8 pk[4];
#pragma unroll
        for (int ks = 0; ks < 4; ++ks) {
            u32x4 w;
            if (ks < 2) { w.x = pg8::cvt_pk_bf16(p0[8 * ks + 0], p0[8 * ks + 1]); w.y = pg8::cvt_pk_bf16(p0[8 * ks + 2], p0[8 * ks + 3]); w.z = pg8::cvt_pk_bf16(p0[8 * ks + 4], p0[8 * ks + 5]); w.w = pg8::cvt_pk_bf16(p0[8 * ks + 6], p0[8 * ks + 7]); }
            else { const int b = 8 * (ks - 2); w.x = pg8::cvt_pk_bf16(p1[b + 0], p1[b + 1]); w.y = pg8::cvt_pk_bf16(p1[b + 2], p1[b + 3]); w.z = pg8::cvt_pk_bf16(p1[b + 4], p1[b + 5]); w.w = pg8::cvt_pk_bf16(p1[b + 6], p1[b + 7]); }
            pk[ks] = __builtin_bit_cast(bf16x8, w);
        }
#pragma unroll
        for (int ks = 0; ks < 4; ++ks) {
            const bf16x8 v0 = *(const bf16x8*)(vb + r32 * 144 + (16 * ks + 8 * hi) * 2);
            const bf16x8 v1 = *(const bf16x8*)(vb + (32 + r32) * 144 + (16 * ks + 8 * hi) * 2);
            o0 = __builtin_amdgcn_mfma_f32_32x32x16_bf16(v0, pk[ks], o0, 0, 0, 0);
            o1 = __builtin_amdgcn_mfma_f32_32x32x16_bf16(v1, pk[ks], o1, 0, 0, 0);
        }
    }
    const float lt = l_run + __shfl_xor(l_run, 32); const float inv = 1.0f / lt;
#pragma unroll
    for (int r = 0; r < 16; ++r) { o0[r] *= inv; o1[r] *= inv; }
    bf16_t* CAT = (bf16_t*)(a.ws + WS_CAT);
    if (is_diff) {
        float* XCH = (float*)(lds + AT_XCH);
        if (sub == 1) {
#pragma unroll
            for (int r = 0; r < 16; ++r) { XCH[(wq * 32 + r) * 64 + lane] = o0[r]; XCH[(wq * 32 + 16 + r) * 64 + lane] = o1[r]; }
        }
        __syncthreads();
        if (sub == 0) {
            float d1 = (lane < 32) ? inptr(I_LQ1)[l * 32 + lane] * inptr(I_LK1)[l * 32 + lane] : 0.f;
            float d2 = (lane < 32) ? inptr(I_LQ2)[l * 32 + lane] * inptr(I_LK2)[l * 32 + lane] : 0.f;
            const float lam_init = (l == 0) ? 0.2f : 0.35550907f;
            const float lam = __expf(wave_sum(d1)) - __expf(wave_sum(d2)) + lam_init;
            float ss = 0.f;
#pragma unroll
            for (int r = 0; r < 16; ++r) { o0[r] -= lam * XCH[(wq * 32 + r) * 64 + lane]; o1[r] -= lam * XCH[(wq * 32 + 16 + r) * 64 + lane]; ss += o0[r] * o0[r] + o1[r] * o1[r]; }
            ss += __shfl_xor(ss, 32);
            const float rs = rsqrtf(ss * (1.0f / 64.0f) + EPS) * (1.0f - lam_init);
            bf16_t* op = CAT + (size_t)qrow * D + 256 + hidx * 64;
#pragma unroll
            for (int g = 0; g < 4; ++g) {
                const int d = 8 * g + 4 * hi; const float* sl = inptr(I_SUBLN) + l * 64;
                u32x2 w0, w1;
                w0.x = pk2(o0[4 * g + 0] * rs * sl[d + 0], o0[4 * g + 1] * rs * sl[d + 1]); w0.y = pk2(o0[4 * g + 2] * rs * sl[d + 2], o0[4 * g + 3] * rs * sl[d + 3]);
                w1.x = pk2(o1[4 * g + 0] * rs * sl[32 + d + 0], o1[4 * g + 1] * rs * sl[32 + d + 1]); w1.y = pk2(o1[4 * g + 2] * rs * sl[32 + d + 2], o1[4 * g + 3] * rs * sl[32 + d + 3]);
                *(u32x2*)(op + d) = w0; *(u32x2*)(op + 32 + d) = w1;
            }
        }
    } else {
        bf16_t* op = CAT + (size_t)qrow * D + 768 + (2 * hidx + sub) * 64;
#pragma unroll
        for (int g = 0; g < 4; ++g) {
            const int d = 8 * g + 4 * hi;
            u32x2 w0, w1;
            w0.x = pk2(o0[4 * g + 0], o0[4 * g + 1]); w0.y = pk2(o0[4 * g + 2], o0[4 * g + 3]);
            w1.x = pk2(o1[4 * g + 0], o1[4 * g + 1]); w1.y = pk2(o1[4 * g + 2], o1[4 * g + 3]);
            *(u32x2*)(op + d) = w0; *(u32x2*)(op + 32 + d) = w1;
        }
    }
    __syncthreads();
}

__device__ __forceinline__ void attn_phase(const Args& a, unsigned char* lds, int l, int rep) {
    unsigned* ctr = (unsigned*)(a.ws + WS_CTL) + 64 * (1 + l + 2 * rep);
    unsigned* slot = (unsigned*)(lds + 131072);
    for (;;) {
        __syncthreads();
        if (threadIdx.x == 0) *slot = atomicAdd(ctr, 1u);
        __syncthreads();
        const int u = (int)*slot;
        if (u >= 384) break;
        bool is_diff, lat; int seq, qb, hidx;
        if (u < 64) { lat = true; is_diff = false; seq = u / 32; const int rem = u % 32; qb = rem >> 1; hidx = rem & 1; }
        else if (u < 192) { const int v = u - 64; lat = true; is_diff = true; seq = v / 64; const int rem = v % 64; qb = rem >> 2; hidx = rem & 3; }
        else if (u < 256) { const int v = u - 192; lat = false; is_diff = false; seq = v >> 2; const int rem = v & 3; qb = rem >> 1; hidx = rem & 1; }
        else { const int v = u - 256; lat = false; is_diff = true; seq = v >> 3; const int rem = v & 7; qb = rem >> 2; hidx = rem & 3; }
        const int qrow0 = lat ? CTX_TOK + seq * SEQ_L + qb * 128 : seq * SEQ_C + qb * 128;
        const int S = lat ? S_LAT : SEQ_C;
        if (is_diff) {
            const bf16_t* Kp = lat ? (const bf16_t*)(a.ws + WS_KDL) + (size_t)seq * S_LAT * 256 : (const bf16_t*)(a.ws + WS_KDC) + (size_t)seq * SEQ_C * 256;
            const bf16_t* Vp = lat ? (const bf16_t*)(a.ws + WS_VDL) + (size_t)seq * S_LAT * 256 : (const bf16_t*)(a.ws + WS_VDC) + (size_t)seq * SEQ_C * 256;
            attn_unit<32>(lds, a, l, true, hidx, qrow0, Kp, Vp, 256, S);
        } else {
            const bf16_t* Kp = lat ? (const bf16_t*)(a.ws + WS_KGL) + (size_t)seq * S_LAT * 128 : (const bf16_t*)(a.ws + WS_KGC) + (size_t)seq * SEQ_C * 128;
            const bf16_t* Vp = lat ? (const bf16_t*)(a.ws + WS_VGL) + (size_t)seq * S_LAT * 128 : (const bf16_t*)(a.ws + WS_VGC) + (size_t)seq * SEQ_C * 128;
            attn_unit<64>(lds, a, l, false, hidx, qrow0, Kp, Vp, 128, S);
        }
    }
}

#define XB_TMO      128
#define XB_XCNT(j)  (256  + 64 * (j))
#define XB_XSUB(j)  (1280 + 64 * (j))
#define XB_XGEN(j)  (2304 + 64 * (j))
#define XB_TOP      3328
#define XB_TOPGEN   3392
#define XCD_BAR_WORDS 3456
#define XB_SPIN_CAP (1u << 18)
__device__ __forceinline__ unsigned xb_ld(unsigned* p)              { return __hip_atomic_load(p, __ATOMIC_RELAXED, __HIP_MEMORY_SCOPE_AGENT); }
__device__ __forceinline__ unsigned xb_add(unsigned* p, unsigned v) { return __hip_atomic_fetch_add(p, v, __ATOMIC_RELAXED, __HIP_MEMORY_SCOPE_AGENT); }
__device__ __forceinline__ unsigned xb_xcc_id() { return (unsigned)__builtin_amdgcn_s_getreg((3 << 11) | 20) & 0xFu; }
#define XB_SPIN(cond, bar) do { unsigned _sp = 0; while (cond) { __builtin_amdgcn_s_sleep(1); \
    if ((++_sp & 255u) == 0u) { if (xb_ld(&(bar)[XB_TMO])) break; if (_sp > XB_SPIN_CAP) { atomicAdd(&(bar)[XB_TMO], 1u); break; } } } } while (0)
struct XcdBarrier { unsigned* bar; unsigned x; volatile LAS unsigned* st; };
__device__ __forceinline__ XcdBarrier xcd_barrier_post(unsigned* bar, volatile LAS unsigned* st) {
    XcdBarrier b; b.bar = bar; b.x = xb_xcc_id(); b.st = st;
    if (threadIdx.x == 0) (void)xb_add(&bar[XB_XCNT(b.x)], 1u);
    return b;
}
__device__ __forceinline__ void xcd_barrier_complete(unsigned* bar, unsigned x, unsigned& nloc, unsigned& nx) {
    const unsigned G = gridDim.x * gridDim.y * gridDim.z;
    unsigned sum, cnt, mine, sp = 0u;
    for (;;) {
        sum = 0u; cnt = 0u; mine = 0u;
#pragma unroll 1
        for (unsigned j = 0; j < 16; ++j) { const unsigned c = xb_ld(&bar[XB_XCNT(j)]); sum += c; cnt += (c > 0u) ? 1u : 0u; mine = (j == x) ? c : mine; }
        if (sum == G) break;
        __builtin_amdgcn_s_sleep(1);
        if ((++sp & 255u) == 0u) { if (xb_ld(&bar[XB_TMO])) break; if (sp > XB_SPIN_CAP) { atomicAdd(&bar[XB_TMO], 1u); break; } }
    }
    nloc = mine > 0u ? mine : 1u; nx = cnt > 0u ? cnt : 1u;
}
__device__ __forceinline__ void xcd_barrier(const XcdBarrier& b) {
    asm volatile("s_waitcnt vmcnt(0)" ::: "memory");
    __syncthreads();
    if (threadIdx.x == 0) {
        unsigned* bar = b.bar;
        __builtin_amdgcn_s_waitcnt(0);
        unsigned nloc = b.st[0], nx = b.st[1];
        if (nloc == 0u) { xcd_barrier_complete(bar, b.x, nloc, nx); b.st[0] = nloc; b.st[1] = nx; }
        const unsigned old = xb_add(&bar[XB_XSUB(b.x)], 1u);
        const unsigned gen = old / nloc;
        if (old + 1u == (gen + 1u) * nloc) {
            __builtin_amdgcn_fence(__ATOMIC_RELEASE, "agent");
            asm volatile("s_waitcnt vmcnt(0)" ::: "memory");
            const unsigned og = xb_add(&bar[XB_TOP], 1u);
            const unsigned tg = og / nx;
            if (og + 1u == (tg + 1u) * nx) xb_add(&bar[XB_TOPGEN], 1u);
            else XB_SPIN(xb_ld(&bar[XB_TOPGEN]) == tg, bar);
            __builtin_amdgcn_fence(__ATOMIC_ACQUIRE, "agent");
            xb_add(&bar[XB_XGEN(b.x)], 1u);
            asm volatile("s_waitcnt vmcnt(0)" ::: "memory");
        } else {
            XB_SPIN(xb_ld(&bar[XB_XGEN(b.x)]) == gen, bar);
            __builtin_amdgcn_fence(__ATOMIC_ACQUIRE, "agent");
            asm volatile("s_waitcnt vmcnt(0)" ::: "memory");
        }
    }
    __syncthreads();
}

__global__ void __launch_bounds__(512, 2) fwd_kernel(Args a) {
    extern __shared__ __attribute__((aligned(16))) unsigned char lds[];
    cg::grid_group grid = cg::this_grid();
    const int G = gridDim.x, bx = blockIdx.x;
    const int vcu = (G % 8 == 0) ? (bx % 8) * (G / 8) + bx / 8 : bx;
    const int NGW = G * 8;
    LAS unsigned char* lds3 = (LAS unsigned char*)lds;
    int ph = 0;
    if (threadIdx.x < 16) ((LAS unsigned*)(lds3 + 131072 + 12288))[threadIdx.x] = 0u;
    __syncthreads();
    XcdBarrier bar = xcd_barrier_post((unsigned*)(a.ws + WS_CTL) + 1024, (volatile LAS unsigned*)(lds3 + 131072 + 12288));
    if (a.ph_hi == -12345) grid.sync();
#define RUN(k) (a.ph_lo <= (k) && (k) < a.ph_hi)
#define SEAM() do { if (a.ph_lo <= ph && ph + 1 < a.ph_hi) { for (int rp_ = 0; rp_ < NREP(1); ++rp_) xcd_barrier(bar); } ++ph; } while (0)
#define REP(k) _Pragma("unroll 1") for (int rp_ = 0; rp_ < NREP(k); ++rp_)

    if (RUN(ph)) { REP(2) p0_prologue(a, lds, vcu, NGW); }
    SEAM();
    if (RUN(ph)) mod_finalize(a, vcu, G);
    SEAM();
    for (int l = 0; l < 2; ++l) {
        unsigned char* wl = a.ws + WS_W + (size_t)l * WL;
        if (l == 0) { if (RUN(ph)) norm_phase(a, lds, vcu, NGW, true, false, 0, 0, true, 0, 0); SEAM(); }
        if (RUN(ph)) { pg8::Gemm g{(const bf16_t*)(a.ws + WS_H), (const bf16_t*)(wl + WO_GU1), D}; pg8::StaticOrder S; S.init(TOK, NGU, 1, G, bx, D);
            pg8::EpiSwiGLU E{(bf16_t*)(a.ws + WS_ACT)}; REP(5) pg8::gemm_phase(lds3, g, S, E); }
        SEAM();
        if (RUN(ph)) { pg8::Gemm g{(const bf16_t*)(a.ws + WS_ACT), (const bf16_t*)(wl + WO_D1), DFF}; pg8::StaticOrder S; S.init(TOK, D, 2, G, bx, DFF / 2);
            pg8::EpiBf16 E{(bf16_t*)(a.ws + WS_Y), D, (size_t)TOK * D}; REP(7) pg8::gemm_phase(lds3, g, S, E); }
        SEAM();
        if (RUN(ph)) { if (PROBE == 6) { for (int rp_ = 0; rp_ < 2; ++rp_) norm_phase(a, lds, vcu, NGW, false, true, l, 0, true, l, 1, true); } norm_phase(a, lds, vcu, NGW, l == 0, true, l, 0, true, l, 1); }
        SEAM();
        if (RUN(ph)) { pg8::Gemm g{(const bf16_t*)(a.ws + WS_H), (const bf16_t*)(wl + WO_MI), D}; pg8::MixInOrder S; S.init(G, bx);
            pg8::EpiMixIn E{(bf16_t*)(a.ws + WS_ACT), (bf16_t*)(a.ws + WS_Y)}; REP(8) pg8::gemm_phase(lds3, g, S, E); }
        SEAM();
        if (RUN(ph)) { REP(4) mix_prep(a, lds, l); }
        SEAM();
        if (RUN(ph)) { REP(3) attn_phase(a, lds, l, rp_); }
        SEAM();
        if (RUN(ph)) { pg8::Gemm g{(const bf16_t*)(a.ws + WS_CAT), (const bf16_t*)(wl + WO_MO), D}; pg8::StaticOrder S; S.init(TOK, D, 2, G, bx, D / 2);
            pg8::EpiBf16 E{(bf16_t*)(a.ws + WS_Y), D, (size_t)TOK * D}; REP(7) pg8::gemm_phase(lds3, g, S, E); }
        SEAM();
        if (RUN(ph)) norm_phase(a, lds, vcu, NGW, false, true, l, 1, true, l, 2);
        SEAM();
        if (RUN(ph)) { pg8::Gemm g{(const bf16_t*)(a.ws + WS_H), (const bf16_t*)(wl + WO_GU2), D}; pg8::StaticOrder S; S.init(TOK, NGU, 1, G, bx, D);
            pg8::EpiSwiGLU E{(bf16_t*)(a.ws + WS_ACT)}; REP(5) pg8::gemm_phase(lds3, g, S, E); }
        SEAM();
        if (RUN(ph)) { pg8::Gemm g{(const bf16_t*)(a.ws + WS_ACT), (const bf16_t*)(wl + WO_D2), DFF}; pg8::StaticOrder S; S.init(TOK, D, 2, G, bx, DFF / 2);
            pg8::EpiBf16 E{(bf16_t*)(a.ws + WS_Y), D, (size_t)TOK * D}; REP(7) pg8::gemm_phase(lds3, g, S, E); }
        SEAM();
        if (RUN(ph)) norm_phase(a, lds, vcu, NGW, false, true, l, 2, l == 0, 1, 0);
        SEAM();
    }
#undef RUN
#undef SEAM
}

extern "C" void kernel_launch(void* const* d_in, const int* in_sizes, int n_in, void* d_out, int out_size, void* d_ws, size_t ws_size, hipStream_t stream) {
    static int grid = 0;
    if (grid == 0) {
        if (n_in != 33 || ws_size < WS_END) { fprintf(stderr, "kernel_launch: unexpected n_in %d / ws_size %zu\n", n_in, ws_size); grid = -1; return; }
        int dev = 0, cus = 0, per_cu = 0;
        (void)hipGetDevice(&dev);
        (void)hipDeviceGetAttribute(&cus, hipDeviceAttributeMultiprocessorCount, dev);
        if (hipFuncSetAttribute((const void*)fwd_kernel, hipFuncAttributeMaxDynamicSharedMemorySize, LDS_BYTES) != hipSuccess) { fprintf(stderr, "kernel_launch: hipFuncSetAttribute failed\n"); grid = -1; return; }
        if (hipOccupancyMaxActiveBlocksPerMultiprocessor(&per_cu, (const void*)fwd_kernel, 512, LDS_BYTES) != hipSuccess || per_cu < 1) { fprintf(stderr, "kernel_launch: occupancy query gave %d\n", per_cu); per_cu = 1; }
        (void)hipGetLastError();
        grid = cus * 1;
    }
    if (grid < 0) return;
    (void)hipMemsetAsync((char*)d_ws + WS_CTL, 0, 65536, stream);
    Args a{};
    for (int i = 0; i < 33; ++i) a.in[i] = (const float*)d_in[i];
    a.out = (float*)d_out; a.ws = (unsigned char*)d_ws; a.ph_lo = 0; a.ph_hi = 1000;
    void* args[] = {&a};
    hipError_t e = hipLaunchCooperativeKernel((const void*)fwd_kernel, dim3(grid), dim3(512), args, LDS_BYTES, stream);
    if (e != hipSuccess) fprintf(stderr, "kernel_launch: cooperative launch failed: %s (grid %d)\n", hipGetErrorString(e), grid);
}
```
